# Optimizing an MI355X kernel written in HIP

```python
import math
import jax, jax.numpy as jnp
from jax import lax
import numpy as np

D_MODEL = 4096
BATCH = 1
SEQ = 8192
DEPTH = 4

N_A_LAYERS = DEPTH // 2
N_B_LAYERS = DEPTH - N_A_LAYERS
POOL_WIDTH = D_MODEL
POOL_WINDOWS = (2, 4, 8, 16)
N_POOL_GROUPS = len(POOL_WINDOWS)
POOL_GROUP_DIM = POOL_WIDTH // N_POOL_GROUPS
SB_HEAD_DIM = 128
SB_N_HEADS = D_MODEL // SB_HEAD_DIM
SB_WIDTH = SB_N_HEADS * SB_HEAD_DIM
Q_BLOCK = 128
RMS_EPS = 1e-6

kernel_name = "yoco_pool_stickbreaking_hybrid"


def rms_norm(x, g):
    xf = x.astype(jnp.float32)
    y = xf * lax.rsqrt(jnp.mean(xf * xf, axis=-1, keepdims=True) + RMS_EPS)
    return (y * g.astype(jnp.float32)).astype(x.dtype)


def causal_multiscale_pool(u):
    b, s, _, c = u.shape
    uf = u.astype(jnp.float32)
    csum = jnp.cumsum(uf, axis=1)
    pos = jnp.arange(s)
    outs = []
    for g, w in enumerate(POOL_WINDOWS):
        cg = csum[:, :, g]
        shifted = jnp.pad(cg, ((0, 0), (w, 0), (0, 0)))[:, :s]
        count = jnp.minimum(pos + 1, w).astype(jnp.float32)[None, :, None]
        outs.append((cg - shifted) / count - uf[:, :, g])
    return jnp.stack(outs, axis=2).astype(u.dtype)


def pool_layer(x, pre_g, w_in, w_group, scale, w_out, post_g):
    b, s, _ = x.shape
    h = rms_norm(x, pre_g)
    ug = h @ w_in
    u, gate = jnp.split(ug, 2, axis=-1)
    u = u.reshape(b, s, N_POOL_GROUPS, POOL_GROUP_DIM)
    pooled = causal_multiscale_pool(u)
    mixed = jnp.einsum('bsgc,gcd->bsgd', pooled, w_group).reshape(b, s, POOL_WIDTH)
    y = (mixed * scale * jax.nn.silu(gate)) @ w_out
    return x + rms_norm(y, post_g)


def stick_breaking_attention(q, k, v):
    b, h, s, d = q.shape
    nb = s // Q_BLOCK
    q_blocks = q.reshape(b, h, nb, Q_BLOCK, d).transpose(2, 0, 1, 3, 4)
    kf = k.astype(jnp.float32)
    vf = v.astype(jnp.float32)
    key_pos = jnp.arange(s)
    inv_sqrt_d = 1.0 / math.sqrt(d)

    def one_block(args):
        qb, i = args
        q_pos = i * Q_BLOCK + jnp.arange(Q_BLOCK)
        z = jnp.einsum('bhqd,bhkd->bhqk', qb.astype(jnp.float32), kf) * inv_sqrt_d
        mask = key_pos[None, :] < q_pos[:, None]
        log_1mb = jnp.where(mask, jax.nn.log_sigmoid(-z), 0.0)
        after = lax.cumsum(log_1mb, axis=3, reverse=True) - log_1mb
        a = jnp.where(mask, jnp.exp(jax.nn.log_sigmoid(z) + after), 0.0)
        return jnp.einsum('bhqk,bhkd->bhqd', a, vf)

    out = lax.map(one_block, (q_blocks, jnp.arange(nb)))
    return out.transpose(1, 2, 0, 3, 4).reshape(b, h, s, d).astype(q.dtype)


def sb_layer(x, k, v, pre_g, w_in, w_out, post_g):
    b, s, _ = x.shape
    h = rms_norm(x, pre_g)
    qg = h @ w_in
    q, gate = jnp.split(qg, 2, axis=-1)
    q = q.reshape(b, s, SB_N_HEADS, SB_HEAD_DIM).transpose(0, 2, 1, 3)
    o = stick_breaking_attention(q, k, v)
    o = o.transpose(0, 2, 1, 3).reshape(b, s, SB_WIDTH)
    y = (o * jax.nn.silu(gate)) @ w_out
    return x + rms_norm(y, post_g)


def setup_inputs(seed: int = 0) -> dict:
    key = jax.random.key(seed)
    ks = jax.random.split(key, 16)
    f32 = jnp.float32

    def dense(k, shape, fan_in):
        return jax.random.normal(k, shape, f32) * (fan_in ** -0.5)

    def gain(k, shape):
        return 1.0 + 0.05 * jax.random.normal(k, shape, f32)

    return {
        "x": jax.random.normal(ks[0], (BATCH, SEQ, D_MODEL), f32),
        "a_pre_norm": gain(ks[1], (N_A_LAYERS, D_MODEL)),
        "a_w_in": dense(ks[2], (N_A_LAYERS, D_MODEL, 2 * POOL_WIDTH), D_MODEL),
        "a_w_group": dense(ks[3], (N_A_LAYERS, N_POOL_GROUPS, POOL_GROUP_DIM, POOL_GROUP_DIM), POOL_GROUP_DIM),
        "a_scale": gain(ks[4], (N_A_LAYERS, POOL_WIDTH)),
        "a_w_out": dense(ks[5], (N_A_LAYERS, POOL_WIDTH, D_MODEL), POOL_WIDTH),
        "a_post_norm": gain(ks[6], (N_A_LAYERS, D_MODEL)),
        "kv_norm": gain(ks[7], (D_MODEL,)),
        "w_kv": dense(ks[8], (D_MODEL, 2 * SB_WIDTH), D_MODEL),
        "b_pre_norm": gain(ks[9], (N_B_LAYERS, D_MODEL)),
        "b_w_in": dense(ks[10], (N_B_LAYERS, D_MODEL, 2 * SB_WIDTH), D_MODEL),
        "b_w_out": dense(ks[11], (N_B_LAYERS, SB_WIDTH, D_MODEL), SB_WIDTH),
        "b_post_norm": gain(ks[12], (N_B_LAYERS, D_MODEL)),
    }


def reference(x, a_pre_norm, a_w_in, a_w_group, a_scale, a_w_out, a_post_norm,
              kv_norm, w_kv, b_pre_norm, b_w_in, b_w_out, b_post_norm):
    b, s, _ = x.shape
    k = None
    v = None
    for layer in range(DEPTH):
        if layer < N_A_LAYERS:
            x = pool_layer(x, a_pre_norm[layer], a_w_in[layer], a_w_group[layer],
                           a_scale[layer], a_w_out[layer], a_post_norm[layer])
            if layer == N_A_LAYERS - 1:
                kv = rms_norm(x, kv_norm) @ w_kv
                k, v = jnp.split(kv, 2, axis=-1)
                k = k.reshape(b, s, SB_N_HEADS, SB_HEAD_DIM).transpose(0, 2, 1, 3)
                v = v.reshape(b, s, SB_N_HEADS, SB_HEAD_DIM).transpose(0, 2, 1, 3)
        else:
            j = layer - N_A_LAYERS
            x = sb_layer(x, k, v, b_pre_norm[j], b_w_in[j], b_w_out[j], b_post_norm[j])
    return x
```

```cpp
#include <hip/hip_runtime.h>
#include <cstdio>
#include <cstdint>

#ifndef SB_EARLY_EXIT
#define SB_EARLY_EXIT 1
#endif

namespace pg8 {
#define PG8_LAS __attribute__((address_space(3)))
typedef unsigned short bf16_t;
typedef short bf16x8 __attribute__((ext_vector_type(8)));
typedef float f32x4 __attribute__((ext_vector_type(4)));
typedef unsigned u32x4 __attribute__((ext_vector_type(4)));
constexpr int BM = 256, BK = 64, HALF = 128, HTB = HALF * BK * 2  , STAGE_BYTES = 8 * HTB, NXCD = 8, WGM = 8;

__host__ __device__ __forceinline__ int lds_byte(int r, int c) { const int st = (r >> 4) * 2 + (c >> 5), rr = r & 15, cc = c & 31, ob = rr * 64 + cc * 2; return st * 1024 + (ob ^ (((ob >> 9) & 1) << 5)); }
__host__ __device__ __forceinline__ void stage_rc(int b, int& R, int& C) { const int st = b / 1024, sb = b % 1024, swz = sb ^ (((sb >> 9) & 1) << 5); R = (st >> 1) * 16 + swz / 64; C = (st & 1) * 32 + (swz % 64) / 2; }
__host__ __device__ __forceinline__ int perm32(int rho) { const int n = rho >> 4, i = rho & 15; return 8 * (i >> 2) + 4 * n + (i & 3); }

struct Unit { int pm, pn; };
struct Gemm { const bf16_t* A; const bf16_t* Bt; int M, N, K, lda, ldb, agdiv; };

struct StaticOrder {
    int nM, nN, nwg, G, c;
    __host__ __device__ void init(int M, int N, int G_, int c_) { nM = M / BM; nN = N / BM; nwg = nM * nN; G = G_; c = c_; }
    __host__ __device__ bool next(int i, Unit& u) const {
        const long L = (long)i * G + c; if (L >= nwg) return false;
        int wgid = (int)L; { const int q = nwg / NXCD, r = nwg % NXCD, xcd = wgid % NXCD, off = wgid / NXCD; wgid = (xcd < r ? xcd * (q + 1) : r * (q + 1) + (xcd - r) * q) + off; }
        const int nig = WGM * nN, gid = wgid / nig, fm = gid * WGM, gsz = (nM - fm) < WGM ? (nM - fm) : WGM;
        u.pm = fm + ((wgid % nig) % gsz); u.pn = (wgid % nig) / gsz; return true;
    }
    __device__ __forceinline__ void a_ready(const Unit&) const {}
    __device__ __forceinline__ void done(const Unit&) const {}
};

__device__ __forceinline__ unsigned cvt_pk_bf16(float lo, float hi) { unsigned r; asm volatile("v_cvt_pk_bf16_f32 %0, %1, %2" : "=v"(r) : "v"(lo), "v"(hi)); return r; }
__device__ __forceinline__ float bf_lo(unsigned w) { return __uint_as_float(w << 16); }
__device__ __forceinline__ float bf_hi(unsigned w) { return __uint_as_float(w & 0xffff0000u); }
__device__ __forceinline__ float silu_f(float v) { const float e = __builtin_amdgcn_exp2f(v * -1.4426950408889634f); return v * __builtin_amdgcn_rcpf(1.0f + e); }

struct EpiF32 {
    static constexpr bool PERM = false, AFTER_DRAIN = false;
    float* C; int ldc;
    __device__ __forceinline__ void operator()(const f32x4 (&acc)[2][2][4][2], const Unit& u, int wr, int wc, int fr, int fq) const {
        const int row0 = u.pm * BM + wr * 64 + fr, col0 = u.pn * BM + wc * 32 + 4 * fq;
#pragma unroll
        for (int ai = 0; ai < 2; ++ai)
#pragma unroll
            for (int m = 0; m < 4; ++m) { float* rowp = C + (size_t)(row0 + ai * HALF + m * 16) * ldc + col0;
#pragma unroll
                for (int bj = 0; bj < 2; ++bj)
#pragma unroll
                    for (int n = 0; n < 2; ++n) *(f32x4*)(rowp + bj * HALF + n * 16) = acc[ai][bj][m][n]; }
    }
};
template <bool HAS_MUL> struct EpiSeg {
    static constexpr bool PERM = true, AFTER_DRAIN = false;
    static constexpr size_t SEG_ELEMS = (size_t)8192 * 4096;
    bf16_t* d; int qseg, gseg; float qscale; const bf16_t* mul;
    __device__ __forceinline__ void operator()(const f32x4 (&acc)[2][2][4][2], const Unit& u, int wr, int wc, int fr, int fq) const {
        const int row0 = u.pm * BM + wr * 64 + fr; int colt = u.pn * BM; const int seg = colt >> 12; colt &= 4095;
        bf16_t* base = d + (size_t)seg * SEG_ELEMS; const float sc = (seg == qseg) ? qscale : 1.0f;
        const bool silu = (seg == gseg);
        const int col0 = colt + wc * 32 + 8 * fq;
#pragma unroll
        for (int ai = 0; ai < 2; ++ai)
#pragma unroll
            for (int m = 0; m < 4; ++m) { const size_t off = (size_t)(row0 + ai * HALF + m * 16) * 4096 + col0;
#pragma unroll
                for (int bj = 0; bj < 2; ++bj) { f32x4 v0 = acc[ai][bj][m][0] * sc, v1 = acc[ai][bj][m][1] * sc;
                    if (silu) {
#pragma unroll
                        for (int j = 0; j < 4; ++j) { v0[j] = silu_f(v0[j]); v1[j] = silu_f(v1[j]); } }
                    if (HAS_MUL) { const u32x4 g = *(const u32x4*)(mul + off + bj * HALF);
                        v0[0] *= bf_lo(g.x); v0[1] *= bf_hi(g.x); v0[2] *= bf_lo(g.y); v0[3] *= bf_hi(g.y); v1[0] *= bf_lo(g.z); v1[1] *= bf_hi(g.z); v1[2] *= bf_lo(g.w); v1[3] *= bf_hi(g.w); }
                    u32x4 w; w.x = cvt_pk_bf16(v0[0], v0[1]); w.y = cvt_pk_bf16(v0[2], v0[3]); w.z = cvt_pk_bf16(v1[0], v1[1]); w.w = cvt_pk_bf16(v1[2], v1[3]);
                    *(u32x4*)(base + off + bj * HALF) = w; } }
    }
};

template <class Epi, class Sched, bool ALIGN_EPI = false, bool SP2 = false>
__device__ __forceinline__ void gemm_phase(PG8_LAS unsigned char* lds, const Gemm g, const Sched& S, const Epi& E) {
    int tid = threadIdx.x; asm volatile("" : "+v"(tid));
    const int wid = __builtin_amdgcn_readfirstlane(tid >> 6), lane = tid & 63, wr = wid >> 2, wc = wid & 3, fr = lane & 15, fq = lane >> 4;
    const int K = g.K, nt = K / BK;
    unsigned voffA[2], voffB[2];
#pragma unroll
    for (int i = 0; i < 2; ++i) { int R, C; stage_rc(tid * 16 + i * 8192, R, C); const int Rb = Epi::PERM ? ((R & ~31) + perm32(R & 31)) : R;
        voffA[i] = (unsigned)(R * g.lda + C) * 2u; voffB[i] = (unsigned)(Rb * g.ldb + C) * 2u; }
    const size_t kstep = (size_t)(BK * 2);
    const size_t hstepA = (size_t)HALF * g.lda * 2, hstepB = (size_t)HALF * g.ldb * 2;
    const size_t tstepA = 2 * hstepA, tstepB = 2 * hstepB;
    const unsigned ldsw = (unsigned)wid * 1024u;
    const int aoff = lds_byte(wr * 64 + fr, fq * 8), boff = lds_byte(wc * 32 + fr, fq * 8);
#define PG8_SA(b, h) (((b) * 2 + (h)) * HTB)
#define PG8_SB(b, h) ((4 + (b) * 2 + (h)) * HTB)
#define PG8_STAGE(bufoff, gbase, voff) do { _Pragma("unroll") for (int _i = 0; _i < 2; ++_i) \
        __builtin_amdgcn_global_load_lds((const unsigned*)((const char*)(gbase) + (voff)[_i]), (PG8_LAS unsigned*)(lds + (bufoff) + ldsw + _i * 8192), 16, 0, 0); } while (0)
#define PG8_LDA(dst, b, h) do { _Pragma("unroll") for (int m = 0; m < 4; ++m) _Pragma("unroll") for (int k = 0; k < 2; ++k) dst[m][k] = *(const PG8_LAS bf16x8*)(lds + PG8_SA(b, h) + aoff + m * 2048 + k * 1024); } while (0)
#define PG8_LDB(dst, b, h) do { _Pragma("unroll") for (int n = 0; n < 2; ++n) _Pragma("unroll") for (int k = 0; k < 2; ++k) dst[n][k] = *(const PG8_LAS bf16x8*)(lds + PG8_SB(b, h) + boff + n * 2048 + k * 1024); } while (0)
#define PG8_MMA(ai, bj, At, Bt) do { __builtin_amdgcn_s_setprio(1); _Pragma("unroll") for (int m = 0; m < 4; ++m) _Pragma("unroll") for (int n = 0; n < 2; ++n) _Pragma("unroll") for (int k = 0; k < 2; ++k) \
        acc[ai][bj][m][n] = __builtin_amdgcn_mfma_f32_16x16x32_bf16(Bt[n][k], At[m][k], acc[ai][bj][m][n], 0, 0, 0); __builtin_amdgcn_s_setprio(0); } while (0)
#define PG8_WAIT_V(n) asm volatile("s_waitcnt vmcnt(" #n ")" ::: "memory")
#define PG8_WAIT_L(n) asm volatile("s_waitcnt lgkmcnt(" #n ")" ::: "memory")
#define PG8_BAR __builtin_amdgcn_s_barrier()
#define PG8_SCHED __builtin_amdgcn_sched_barrier(0)
#define PG8_ABASE(u) ((const char*)g.A + (size_t)(u).pm * tstepA + (size_t)((u).pn / g.agdiv) * (size_t)K * 2)
#define PG8_BBASE(u) ((const char*)g.Bt + (size_t)(u).pn * tstepB)
    Unit cur, nxt; int ui = 0;
    if (!S.next(0, cur)) return;
    f32x4 acc[2][2][4][2];
#pragma unroll
    for (int a = 0; a < 2; ++a)
#pragma unroll
        for (int b = 0; b < 2; ++b)
#pragma unroll
            for (int m = 0; m < 4; ++m)
#pragma unroll
                for (int n = 0; n < 2; ++n) acc[a][b][m][n] = (f32x4){0.f, 0.f, 0.f, 0.f};
    bf16x8 At[4][2], B0[2][2], B1[2][2];
    const char* cA = PG8_ABASE(cur); const char* cB = PG8_BBASE(cur);
    S.a_ready(cur);
    if constexpr (SP2) {
        PG8_STAGE(PG8_SB(0, 0), cB, voffB); PG8_STAGE(PG8_SB(0, 1), cB + hstepB, voffB); PG8_STAGE(PG8_SA(0, 0), cA, voffA); PG8_STAGE(PG8_SA(0, 1), cA + hstepA, voffA);
        if (wr == 1) PG8_BAR;
        PG8_WAIT_V(2); PG8_BAR;
        PG8_STAGE(PG8_SB(1, 0), cB + kstep, voffB); PG8_STAGE(PG8_SA(1, 0), cA + kstep, voffA); PG8_STAGE(PG8_SB(1, 1), cB + hstepB + kstep, voffB);
        PG8_WAIT_V(6); PG8_BAR;
    } else {
        PG8_STAGE(PG8_SB(0, 0), cB, voffB); PG8_STAGE(PG8_SA(0, 0), cA, voffA); PG8_STAGE(PG8_SB(0, 1), cB + hstepB, voffB); PG8_STAGE(PG8_SA(0, 1), cA + hstepA, voffA);
        if (wr == 1) PG8_BAR;
        PG8_WAIT_V(4); PG8_BAR;
        PG8_STAGE(PG8_SB(1, 0), cB + kstep, voffB); PG8_STAGE(PG8_SA(1, 0), cA + kstep, voffA); PG8_STAGE(PG8_SB(1, 1), cB + hstepB + kstep, voffB);
        PG8_WAIT_V(6); PG8_BAR;
    }
    for (;;) {
        const bool has_next = S.next(ui + 1, nxt);
        const char* nA = has_next ? PG8_ABASE(nxt) : cA; const char* nB = has_next ? PG8_BBASE(nxt) : cB;
        for (int t = 0; t < nt; t += 2) {
            const bool last = (t == nt - 2);
            const char* a1 = cA + (size_t)(t + 1) * kstep;
            const char* a2 = last ? nA : cA + (size_t)(t + 2) * kstep; const char* b2 = last ? nB : cB + (size_t)(t + 2) * kstep;
            const char* a3 = a2 + kstep; const char* b3 = b2 + kstep;
            if (last && has_next) S.a_ready(nxt);
            if constexpr (SP2) {
            PG8_LDB(B0, 0, 0); PG8_LDB(B1, 0, 1); PG8_SCHED; PG8_LDA(At, 0, 0); PG8_STAGE(PG8_SA(1, 1), a1 + hstepA, voffA);
            PG8_WAIT_V(8); PG8_WAIT_L(0); PG8_BAR; PG8_MMA(0, 0, At, B0); PG8_MMA(0, 1, At, B1); PG8_BAR; PG8_SCHED;
            PG8_LDA(At, 0, 1); PG8_STAGE(PG8_SB(0, 0), b2, voffB); PG8_STAGE(PG8_SB(0, 1), b2 + hstepB, voffB); PG8_STAGE(PG8_SA(0, 0), a2, voffA);
            PG8_WAIT_V(8); PG8_WAIT_L(0); PG8_BAR; PG8_MMA(1, 0, At, B0); PG8_MMA(1, 1, At, B1); PG8_BAR; PG8_SCHED;
            PG8_LDB(B0, 1, 0); PG8_LDB(B1, 1, 1); PG8_SCHED; PG8_LDA(At, 1, 0); PG8_STAGE(PG8_SA(0, 1), a2 + hstepA, voffA);
            PG8_WAIT_V(8); PG8_WAIT_L(0); PG8_BAR; PG8_MMA(0, 0, At, B0); PG8_MMA(0, 1, At, B1); PG8_BAR; PG8_SCHED;
            PG8_LDA(At, 1, 1); PG8_STAGE(PG8_SB(1, 0), b3, voffB); PG8_STAGE(PG8_SB(1, 1), b3 + hstepB, voffB); PG8_STAGE(PG8_SA(1, 0), a3, voffA);
            PG8_WAIT_V(8); PG8_WAIT_L(0); PG8_BAR; PG8_MMA(1, 0, At, B0); PG8_MMA(1, 1, At, B1); PG8_BAR; PG8_SCHED;
            } else {
            PG8_LDB(B0, 0, 0); PG8_SCHED; PG8_LDA(At, 0, 0); PG8_STAGE(PG8_SA(1, 1), a1 + hstepA, voffA);
            PG8_WAIT_L(8); PG8_BAR; PG8_WAIT_L(0); PG8_MMA(0, 0, At, B0); PG8_BAR; PG8_SCHED;
            PG8_LDB(B1, 0, 1); PG8_STAGE(PG8_SB(0, 0), b2, voffB);
            PG8_BAR; PG8_WAIT_L(0); PG8_MMA(0, 1, At, B1); PG8_BAR;
            PG8_LDA(At, 0, 1); PG8_STAGE(PG8_SA(0, 0), a2, voffA);
            PG8_BAR; PG8_WAIT_L(0); PG8_MMA(1, 0, At, B0); PG8_BAR; PG8_SCHED;
            PG8_STAGE(PG8_SB(0, 1), b2 + hstepB, voffB);
            PG8_WAIT_V(6); PG8_BAR; PG8_MMA(1, 1, At, B1); PG8_BAR;
            PG8_LDB(B0, 1, 0); PG8_SCHED; PG8_LDA(At, 1, 0); PG8_STAGE(PG8_SA(0, 1), a2 + hstepA, voffA);
            PG8_WAIT_L(8); PG8_BAR; PG8_WAIT_L(0); PG8_MMA(0, 0, At, B0); PG8_BAR; PG8_SCHED;
            PG8_LDB(B1, 1, 1); PG8_STAGE(PG8_SB(1, 0), b3, voffB);
            PG8_BAR; PG8_WAIT_L(0); PG8_MMA(0, 1, At, B1); PG8_BAR;
            PG8_LDA(At, 1, 1); PG8_STAGE(PG8_SA(1, 0), a3, voffA);
            PG8_BAR; PG8_WAIT_L(0); PG8_MMA(1, 0, At, B0); PG8_BAR; PG8_SCHED;
            PG8_STAGE(PG8_SB(1, 1), b3 + hstepB, voffB);
            PG8_WAIT_V(6); PG8_BAR; PG8_MMA(1, 1, At, B1); PG8_BAR;
            }
        }
        if constexpr (ALIGN_EPI) { if (wr == 0) PG8_BAR; }
        E(acc, cur, wr, wc, fr, fq); S.done(cur);
        if (!has_next) break;
#pragma unroll
        for (int a = 0; a < 2; ++a)
#pragma unroll
            for (int b = 0; b < 2; ++b)
#pragma unroll
                for (int m = 0; m < 4; ++m)
#pragma unroll
                    for (int n = 0; n < 2; ++n) acc[a][b][m][n] = (f32x4){0.f, 0.f, 0.f, 0.f};
        cur = nxt; cA = nA; cB = nB; ++ui;
        if constexpr (ALIGN_EPI) { if (wr == 1) PG8_BAR; }
    }
    PG8_WAIT_V(0);
    if constexpr (!ALIGN_EPI) { if (wr == 0) PG8_BAR; }
    PG8_BAR;
#undef PG8_SA
#undef PG8_SB
#undef PG8_STAGE
#undef PG8_LDA
#undef PG8_LDB
#undef PG8_MMA
#undef PG8_WAIT_V
#undef PG8_WAIT_L
#undef PG8_BAR
#undef PG8_SCHED
#undef PG8_ABASE
#undef PG8_BBASE
}
}

#ifndef PG8_SP2
#define PG8_SP2 true
#endif
#ifndef PG8_ALIGN
#define PG8_ALIGN true
#endif

#define GAS __attribute__((address_space(1)))
#define LAS __attribute__((address_space(3)))
typedef unsigned short bf16;
typedef unsigned v4u __attribute__((ext_vector_type(4)));
typedef unsigned v2u __attribute__((ext_vector_type(2)));
typedef float f32x4 __attribute__((ext_vector_type(4)));
typedef short bf16x8 __attribute__((ext_vector_type(8)));
typedef short s16x4 __attribute__((ext_vector_type(4)));
typedef float f32x16 __attribute__((ext_vector_type(16)));
typedef GAS unsigned gu32;
#define RLX_AGENT __ATOMIC_RELAXED, __HIP_MEMORY_SCOPE_AGENT
#define LDS_WAIT() asm volatile("s_waitcnt lgkmcnt(0)" ::: "memory")
#define VM_WAIT() asm volatile("s_waitcnt vmcnt(0)" ::: "memory")
__device__ __forceinline__ unsigned cvtpk(float lo, float hi) { unsigned r; asm volatile("v_cvt_pk_bf16_f32 %0, %1, %2" : "=v"(r) : "v"(lo), "v"(hi)); return r; }
__device__ __forceinline__ float bflo(unsigned w) { return __uint_as_float(w << 16); }
__device__ __forceinline__ float bfhi(unsigned w) { return __uint_as_float(w & 0xffff0000u); }

#define XB_TMO      128
#define XB_XCNT(j)  (256  + 64 * (j))
#define XB_XSUB(j)  (1280 + 64 * (j))
#define XB_XGEN(j)  (2304 + 64 * (j))
#define XB_TOP      3328
#define XB_TOPGEN   3392
#define XCD_BAR_WORDS 3456
#define XB_SPIN_CAP (1u << 18)

__device__ __forceinline__ unsigned xb_ld(unsigned* p)              { return __hip_atomic_load(p, __ATOMIC_RELAXED, __HIP_MEMORY_SCOPE_AGENT); }
__device__ __forceinline__ unsigned xb_add(unsigned* p, unsigned v) { return __hip_atomic_fetch_add(p, v, __ATOMIC_RELAXED, __HIP_MEMORY_SCOPE_AGENT); }
__device__ __forceinline__ unsigned xb_xcc_id() { return (unsigned)__builtin_amdgcn_s_getreg((3 << 11) | 20) & 0xFu; }
#define XB_SPIN(cond, bar) do { unsigned _sp = 0; while (cond) { __builtin_amdgcn_s_sleep(1); \
    if ((++_sp & 255u) == 0u) { if (xb_ld(&(bar)[XB_TMO])) break; if (_sp > XB_SPIN_CAP) { atomicAdd(&(bar)[XB_TMO], 1u); break; } } } } while (0)

struct XcdBarrier {
    unsigned* bar; unsigned x;
    volatile LAS unsigned* st;
};
__device__ __forceinline__ XcdBarrier xcd_barrier_post(unsigned* bar, volatile LAS unsigned* st) {
    XcdBarrier b; b.bar = bar; b.x = xb_xcc_id(); b.st = st;
    if (threadIdx.x == 0) (void)xb_add(&bar[XB_XCNT(b.x)], 1u);
    return b;
}
__device__ __forceinline__ void xcd_barrier_complete(unsigned* bar, unsigned x, unsigned& nloc, unsigned& nx) {
    const unsigned G = gridDim.x * gridDim.y * gridDim.z;
    unsigned sum, cnt, mine, sp = 0u;
    for (;;) {
        sum = 0u; cnt = 0u; mine = 0u;
#pragma unroll
        for (unsigned j = 0; j < 16; ++j) { const unsigned c = xb_ld(&bar[XB_XCNT(j)]); sum += c; cnt += (c > 0u) ? 1u : 0u; mine = (j == x) ? c : mine; }
        if (sum == G) break;
        __builtin_amdgcn_s_sleep(1);
        if ((++sp & 255u) == 0u) { if (xb_ld(&bar[XB_TMO])) break; if (sp > XB_SPIN_CAP) { atomicAdd(&bar[XB_TMO], 1u); break; } }
    }
    nloc = mine > 0u ? mine : 1u; nx = cnt > 0u ? cnt : 1u;
}
__device__ __forceinline__ void xcd_barrier(const XcdBarrier& b) {
    asm volatile("s_waitcnt vmcnt(0)" ::: "memory");
    __syncthreads();
    if (threadIdx.x == 0) {
        unsigned* bar = b.bar;
        __builtin_amdgcn_s_waitcnt(0);
        unsigned nloc = b.st[0], nx = b.st[1];
        if (nloc == 0u) { xcd_barrier_complete(bar, b.x, nloc, nx); b.st[0] = nloc; b.st[1] = nx; }
        const unsigned old = xb_add(&bar[XB_XSUB(b.x)], 1u);
        const unsigned gen = old / nloc;
        if (old + 1u == (gen + 1u) * nloc) {
            __builtin_amdgcn_fence(__ATOMIC_RELEASE, "agent");
            asm volatile("s_waitcnt vmcnt(0)" ::: "memory");
            const unsigned og = xb_add(&bar[XB_TOP], 1u);
            const unsigned tg = og / nx;
            if (og + 1u == (tg + 1u) * nx) xb_add(&bar[XB_TOPGEN], 1u);
            else XB_SPIN(xb_ld(&bar[XB_TOPGEN]) == tg, bar);
            __builtin_amdgcn_fence(__ATOMIC_ACQUIRE, "agent");
            xb_add(&bar[XB_XGEN(b.x)], 1u);
            asm volatile("s_waitcnt vmcnt(0)" ::: "memory");
        } else {
            XB_SPIN(xb_ld(&bar[XB_XGEN(b.x)]) == gen, bar);
            __builtin_amdgcn_fence(__ATOMIC_ACQUIRE, "agent");
            asm volatile("s_waitcnt vmcnt(0)" ::: "memory");
        }
    }
    __syncthreads();
}

constexpr int NWAVES = 8;
constexpr int S = 8192, DM = 4096, NH = 32, HD = 128;
constexpr float RMS_EPS = 1e-6f;
constexpr float QSCALE = 0.08838834764831845f * 1.4426950408889634f;

constexpr size_t MiB = 1u << 20;
constexpr size_t WS_CTL = 0, CTL_ZERO_BYTES = 1 * MiB;
constexpr size_t WS_WAIN = 16 * MiB;
constexpr size_t WS_WAG = 144 * MiB;
constexpr size_t WS_WAOUT = 160 * MiB;
constexpr size_t WS_WKVQ = 224 * MiB;
constexpr size_t WS_WBIN1 = 352 * MiB;
constexpr size_t WS_WBOUT = 416 * MiB;
constexpr size_t WS_HB = 480 * MiB;
constexpr size_t WS_K = 544 * MiB;
constexpr size_t WS_V = 608 * MiB;
constexpr size_t WS_U = 672 * MiB;
constexpr size_t WS_SG = 736 * MiB;
constexpr size_t WS_PO = 800 * MiB;
constexpr size_t WS_Y = WS_SG;
constexpr size_t WS_END = 864 * MiB;
static_assert(WS_V == WS_K + 64 * MiB && WS_U == WS_V + 64 * MiB && WS_SG == WS_U + 64 * MiB && WS_PO == WS_SG + 64 * MiB, "EpiSeg segment layout");
constexpr int CW_BAR = 4096;

constexpr int RING_OFF = 0, RING_BYTES = 131072;
constexpr int LDSCTL_OFF = RING_BYTES, MISC_OFF = LDSCTL_OFF + 320;
constexpr int LDS_BYTES = 147456;
static_assert(MISC_OFF + 128 <= LDS_BYTES, "LDS map");

__device__ __forceinline__ float wave_sum(float v) {
#pragma unroll
    for (int o = 1; o < 64; o <<= 1) v += __shfl_xor(v, o);
    return v;
}

__device__ __forceinline__ void transpose_item(const float* __restrict__ W, int K, int N, bf16* __restrict__ WT, int ldt, int row_off, const float* __restrict__ gk, const float* __restrict__ gn,
                                               LAS unsigned char* scr, int item, int lane) {
    const int nblk = N >> 6, kb = item / nblk, nb = item - kb * nblk, k0 = kb << 6, n0 = nb << 6;
    const int nq = lane & 15, kr = lane >> 4;
    f32x4 va[8], vb[8];
#pragma unroll
    for (int i = 0; i < 8; ++i) { const int kp = 4 * i + kr; const float* p = W + (size_t)(k0 + 2 * kp) * N + n0 + 4 * nq; va[i] = *(const f32x4*)p; vb[i] = *(const f32x4*)(p + N); }
    f32x4 gnv = (f32x4){1.f, 1.f, 1.f, 1.f}; if (gn) gnv = *(const f32x4*)(gn + n0 + 4 * nq);
    LAS unsigned* s32 = (LAS unsigned*)scr;
#pragma unroll
    for (int i = 0; i < 8; ++i) { const int kp = 4 * i + kr; float ga = 1.f, gb = 1.f; if (gk) { ga = gk[k0 + 2 * kp]; gb = gk[k0 + 2 * kp + 1]; }
        const f32x4 a = va[i] * ga * gnv, b = vb[i] * gb * gnv; const int wsw = kp ^ (4 * (nq & 7));
#pragma unroll
        for (int j = 0; j < 4; ++j) s32[(4 * nq + j) * 32 + wsw] = cvtpk(a[j], b[j]); }
    LDS_WAIT(); asm volatile("" ::: "memory");
    const int c = lane & 7;
#pragma unroll
    for (int pass = 0; pass < 8; ++pass) { const int n = (lane >> 3) + 8 * pass; const int ch = c ^ ((n >> 2) & 7);
        const v4u v = *(const LAS v4u*)(scr + n * 128 + ch * 16);
        *(v4u*)(WT + (size_t)(row_off + n0 + n) * ldt + k0 + 8 * c) = v; }
    LDS_WAIT(); asm volatile("" ::: "memory");
}
__device__ __forceinline__ void rms_row_to_bf16(const float* __restrict__ xrow, bf16* __restrict__ orow, int lane) {
    const f32x4* xr = (const f32x4*)xrow + lane;
    f32x4 v[16]; float s = 0.f;
#pragma unroll
    for (int j = 0; j < 16; ++j) { v[j] = xr[64 * j]; s += (v[j].x * v[j].x + v[j].y * v[j].y) + (v[j].z * v[j].z + v[j].w * v[j].w); }
    const float rstd = 1.0f / sqrtf(wave_sum(s) * (1.f / DM) + RMS_EPS);
    v2u* o8 = (v2u*)orow + lane;
#pragma unroll
    for (int j = 0; j < 16; ++j) { v2u w; w.x = cvtpk(v[j].x * rstd, v[j].y * rstd); w.y = cvtpk(v[j].z * rstd, v[j].w * rstd); o8[64 * j] = w; }
}
__device__ __forceinline__ void norm_res_row(const float* xrow, const float* __restrict__ yrow, const float* __restrict__ g, float* xout, bf16* __restrict__ hout, int lane) {
    const f32x4* yr = (const f32x4*)yrow + lane; const f32x4* xr = (const f32x4*)xrow + lane; const f32x4* gr = (const f32x4*)g + lane;
    f32x4 y[16], x[16]; float s = 0.f;
#pragma unroll
    for (int j = 0; j < 16; ++j) { y[j] = yr[64 * j]; x[j] = xr[64 * j]; }
#pragma unroll
    for (int j = 0; j < 16; ++j) s += (y[j].x * y[j].x + y[j].y * y[j].y) + (y[j].z * y[j].z + y[j].w * y[j].w);
    const float r1 = 1.0f / sqrtf(wave_sum(s) * (1.f / DM) + RMS_EPS);
    float s2 = 0.f;
#pragma unroll
    for (int j = 0; j < 16; ++j) { const f32x4 gg = gr[64 * j]; x[j] = x[j] + (y[j] * r1) * gg; s2 += (x[j].x * x[j].x + x[j].y * x[j].y) + (x[j].z * x[j].z + x[j].w * x[j].w); }
    f32x4* xo = (f32x4*)xout + lane;
#pragma unroll
    for (int j = 0; j < 16; ++j) xo[64 * j] = x[j];
    if (hout) { const float r2 = 1.0f / sqrtf(wave_sum(s2) * (1.f / DM) + RMS_EPS); v2u* o8 = (v2u*)hout + lane;
#pragma unroll
        for (int j = 0; j < 16; ++j) { v2u w; w.x = cvtpk(x[j].x * r2, x[j].y * r2); w.y = cvtpk(x[j].z * r2, x[j].w * r2); o8[64 * j] = w; } }
}
__device__ __forceinline__ void ld8f(const bf16* p, float (&f)[8]) { const v4u w = *(const v4u*)p; f[0] = bflo(w.x); f[1] = bfhi(w.x); f[2] = bflo(w.y); f[3] = bfhi(w.y); f[4] = bflo(w.z); f[5] = bfhi(w.z); f[6] = bflo(w.w); f[7] = bfhi(w.w); }
__device__ __forceinline__ void pool_block(const bf16* __restrict__ U, bf16* __restrict__ PO, int rb, int tid) {
    const int c0 = tid * 8, w = 2 << (c0 >> 10), r0 = rb * 32;
    float s[8] = {0.f, 0.f, 0.f, 0.f, 0.f, 0.f, 0.f, 0.f};
    for (int tt = r0 - w + 1; tt < r0; ++tt) if (tt >= 0) { float f[8]; ld8f(U + (size_t)tt * DM + c0, f);
#pragma unroll
        for (int j = 0; j < 8; ++j) s[j] += f[j]; }
    for (int t = r0; t < r0 + 32; ++t) {
        float cur[8]; ld8f(U + (size_t)t * DM + c0, cur);
        const int cnt = (t + 1 < w) ? (t + 1) : w; const float inv = 1.0f / (float)cnt;
        float o[8];
#pragma unroll
        for (int j = 0; j < 8; ++j) { s[j] += cur[j]; o[j] = s[j] * inv - cur[j]; }
        v4u wv; wv.x = cvtpk(o[0], o[1]); wv.y = cvtpk(o[2], o[3]); wv.z = cvtpk(o[4], o[5]); wv.w = cvtpk(o[6], o[7]);
        *(v4u*)(PO + (size_t)t * DM + c0) = wv;
        const int ts = t - w + 1;
        if (ts >= 0) { float f[8]; ld8f(U + (size_t)ts * DM + c0, f);
#pragma unroll
            for (int j = 0; j < 8; ++j) s[j] -= f[j]; }
    }
}

namespace sb {
constexpr int NW = 8, QBLK = 32, QB = NW * QBLK, KVBLK = 64, PITCH = DM;
constexpr int SHM_V = KVBLK * HD * 2, SHM_K = KVBLK * HD * 2;
constexpr int LDS_V = 0, LDS_K = 2 * SHM_V, LDS_OST = 2 * SHM_V + 2 * SHM_K  , LDS_FLAG = LDS_OST + NW * 8192, LDS_TOTAL = LDS_FLAG + 64;
static_assert(LDS_TOTAL <= RING_BYTES + 320, "attention LDS");
#define KSWZ(row, colB) ((row) * 256 + ((colB) ^ (((row) & 7) << 4)))
#define SBAR() __builtin_amdgcn_sched_barrier(0)
__device__ __forceinline__ int v_st(int k, int c) { const int kk = (k & ~0xC) | ((k & 4) << 1) | ((k & 8) >> 1); return ((kk >> 3) * 4 + (c >> 5)) * 512 + ((kk & 7) * 32 + (c & 31)) * 2; }
__device__ __forceinline__ int v_rd_base(int lane) { return ((lane & 3) << 3) | (((lane >> 2) & 3) << 6) | (((lane >> 4) & 1) << 5) | (((lane >> 5) & 1) << 8); }
constexpr int v_rd_off(int d0, int ks, int half) { return d0 * 512 + ks * 4096 + half * 2048; }
__device__ __forceinline__ int crow(int r, int hi) { return (r & 3) + 8 * (r >> 2) + 4 * hi; }

__device__ __forceinline__ void qkt(f32x16& p0, f32x16& p1, const LAS char* Kb, int r32, int hi, const bf16x8* qr) {
    p0 = f32x16{}; p1 = f32x16{};
    const LAS char* kb[4];
#pragma unroll
    for (int dd = 0; dd < 4; ++dd) kb[dd] = Kb + KSWZ(r32, (dd * 16 + hi * 8) * 2);
#pragma unroll
    for (int d0 = 0; d0 < 8; ++d0) { const LAS char* a = kb[d0 & 3] + (d0 >> 2) * 128;
        const bf16x8 b0 = *(const LAS bf16x8*)a;
        const bf16x8 b1 = *(const LAS bf16x8*)(a + 32 * 256);
        p0 = __builtin_amdgcn_mfma_f32_32x32x16_bf16(b0, qr[d0], p0, 0, 0, 0);
        p1 = __builtin_amdgcn_mfma_f32_32x32x16_bf16(b1, qr[d0], p1, 0, 0, 0); }
}
__device__ __forceinline__ void pv_tile(f32x16* o, int vb, bf16x8 pa0, bf16x8 pa1, bf16x8 pa2, bf16x8 pa3) {
#define TRRD(dst, off) asm volatile("ds_read_b64_tr_b16 %0, %1 offset:%2" : "=&v"(dst) : "v"(vb), "i"(off) : "memory")
#define PV_D0(d0) do { s16x4 l0, l1, l2, l3, h0, h1, h2, h3; constexpr int b_ = v_rd_off(d0, 0, 0); \
        TRRD(l0, b_); TRRD(h0, b_ + 2048); TRRD(l1, b_ + 4096); TRRD(h1, b_ + 6144); TRRD(l2, b_ + 8192); TRRD(h2, b_ + 10240); TRRD(l3, b_ + 12288); TRRD(h3, b_ + 14336); \
        asm volatile("s_waitcnt lgkmcnt(0)" ::: "memory"); SBAR(); \
        o[d0] = __builtin_amdgcn_mfma_f32_32x32x16_bf16(pa0, (bf16x8){l0[0], l0[1], l0[2], l0[3], h0[0], h0[1], h0[2], h0[3]}, o[d0], 0, 0, 0); \
        o[d0] = __builtin_amdgcn_mfma_f32_32x32x16_bf16(pa1, (bf16x8){l1[0], l1[1], l1[2], l1[3], h1[0], h1[1], h1[2], h1[3]}, o[d0], 0, 0, 0); \
        o[d0] = __builtin_amdgcn_mfma_f32_32x32x16_bf16(pa2, (bf16x8){l2[0], l2[1], l2[2], l2[3], h2[0], h2[1], h2[2], h2[3]}, o[d0], 0, 0, 0); \
        o[d0] = __builtin_amdgcn_mfma_f32_32x32x16_bf16(pa3, (bf16x8){l3[0], l3[1], l3[2], l3[3], h3[0], h3[1], h3[2], h3[3]}, o[d0], 0, 0, 0); } while (0)
    PV_D0(0); PV_D0(1); PV_D0(2); PV_D0(3);
#undef PV_D0
#undef TRRD
}
__device__ __forceinline__ void sb_weights(f32x16& p0, f32x16& p1, float& C, int hi, bf16x8& pa0, bf16x8& pa1, bf16x8& pa2, bf16x8& pa3) {
    float G[8];
#pragma unroll
    for (int Q = 0; Q < 8; ++Q) {
        f32x16& p = (Q < 4) ? p0 : p1; const int rb = (Q & 3) * 4;
        const float o0 = __builtin_amdgcn_rcpf(1.0f + __builtin_amdgcn_exp2f(p[rb + 0])), o1 = __builtin_amdgcn_rcpf(1.0f + __builtin_amdgcn_exp2f(p[rb + 1]));
        const float o2 = __builtin_amdgcn_rcpf(1.0f + __builtin_amdgcn_exp2f(p[rb + 2])), o3 = __builtin_amdgcn_rcpf(1.0f + __builtin_amdgcn_exp2f(p[rb + 3]));
        const float E1 = o3 * o2, E0 = E1 * o1; G[Q] = E0 * o0;
        p[rb + 3] = 1.0f - o3; p[rb + 2] = o3 - E1; p[rb + 1] = E1 - E0; p[rb + 0] = E0 - G[Q];
    }
    float R = C;
#pragma unroll
    for (int Q = 7; Q >= 0; --Q) {
        f32x16& p = (Q < 4) ? p0 : p1; const int rb = (Q & 3) * 4;
        const auto rr = __builtin_amdgcn_permlane32_swap(__float_as_uint(G[Q]), __float_as_uint(G[Q]), false, false);
        const float g0 = __uint_as_float(rr[0]), g1 = __uint_as_float(rr[1]);
        const float X = R * g1;
        const float Sq = hi ? R : X;
        R = X * g0;
        p[rb + 0] *= Sq; p[rb + 1] *= Sq; p[rb + 2] *= Sq; p[rb + 3] *= Sq;
    }
    C = R;
#define PK4(P, B_, OUT) do { const unsigned a0 = cvtpk(P[B_ + 0], P[B_ + 1]), a1 = cvtpk(P[B_ + 2], P[B_ + 3]); \
        const unsigned b0 = cvtpk(P[B_ + 4], P[B_ + 5]), b1 = cvtpk(P[B_ + 6], P[B_ + 7]); \
        const auto r0 = __builtin_amdgcn_permlane32_swap(a0, b0, false, false); const auto r1 = __builtin_amdgcn_permlane32_swap(a1, b1, false, false); \
        v4u w = {r0[0], r1[0], r0[1], r1[1]}; OUT = __builtin_bit_cast(bf16x8, w); } while (0)
    PK4(p0, 0, pa0); PK4(p0, 8, pa1); PK4(p1, 0, pa2); PK4(p1, 8, pa3);
#undef PK4
}

__device__ __forceinline__ void attn_unit(int h, int qb, const bf16* Q, const bf16* __restrict__ Kt, const bf16* __restrict__ Vt, const bf16* __restrict__ SG, bf16* O, LAS char* lds) {
    int tid = threadIdx.x; asm volatile("" : "+v"(tid));
    const int wid = __builtin_amdgcn_readfirstlane(tid >> 6), lane = tid & 63, r32 = lane & 31, hi = lane >> 5;
    const int P0 = qb * QB, qlo = P0 + wid * QBLK;
    const bf16* Qh = Q + h * HD; const bf16* Kh = Kt + h * HD; const bf16* Vh = Vt + h * HD;
    LAS char* V_lds = lds + LDS_V; LAS char* K_lds = lds + LDS_K; volatile LAS unsigned* flags = (volatile LAS unsigned*)(lds + LDS_FLAG);
    bf16x8 qr[8];
#pragma unroll
    for (int d0 = 0; d0 < 8; ++d0) qr[d0] = *(const bf16x8*)(Qh + (size_t)(qlo + r32) * PITCH + d0 * 16 + hi * 8);
    const int sr = tid >> 4, sc = (tid & 15) * 8, vst0 = v_st(sr, sc), vst1 = v_st(32 + sr, sc), kws = KSWZ(sr, sc * 2);
    const int vb0 = (int)(unsigned)(uintptr_t)V_lds + v_rd_base(lane);
    bf16x8 st_k0, st_k1, st_v0, st_v1;
#define SLOAD(j) do { const size_t r_ = (size_t)((j) * KVBLK + sr) * PITCH + sc; \
        st_k0 = *(const bf16x8*)(Kh + r_); st_k1 = *(const bf16x8*)(Kh + r_ + (size_t)32 * PITCH); st_v0 = *(const bf16x8*)(Vh + r_); st_v1 = *(const bf16x8*)(Vh + r_ + (size_t)32 * PITCH); } while (0)
#define SWRITE(bf) do { *(LAS bf16x8*)(K_lds + (bf) * SHM_K + kws) = st_k0; *(LAS bf16x8*)(K_lds + (bf) * SHM_K + kws + 32 * 256) = st_k1; \
        *(LAS bf16x8*)(V_lds + (bf) * SHM_V + vst0) = st_v0; *(LAS bf16x8*)(V_lds + (bf) * SHM_V + vst1) = st_v1; } while (0)
    const int j_hi = 4 * qb + 4;
    SLOAD(j_hi - 1);
    VM_WAIT(); SWRITE(0);
    __syncthreads();
    float C = 1.0f; bool done = false; f32x16 o[4] = {};
    for (int t = 0;; ++t) {
        const int j = j_hi - 1 - t, buf = t & 1;
        if (j > 0) SLOAD(j - 1);
        const bool act = !done && (j * KVBLK <= qlo + QBLK - 1);
        if (act) {
            f32x16 p0, p1; bf16x8 pa0, pa1, pa2, pa3;
            qkt(p0, p1, K_lds + buf * SHM_K, r32, hi, qr);
            if (j * KVBLK + KVBLK - 1 >= qlo) {
                const int dq = qlo + r32 - 4 * hi - j * KVBLK; const float NEG = -__builtin_inff();
#pragma unroll
                for (int r = 0; r < 16; ++r) { const int c = (r & 3) + 8 * (r >> 2); if (dq - c <= 0) p0[r] = NEG; if (dq - c - 32 <= 0) p1[r] = NEG; }
            }
            sb_weights(p0, p1, C, hi, pa0, pa1, pa2, pa3);
            pv_tile(o, vb0 + buf * SHM_V, pa0, pa1, pa2, pa3);
#if SB_EARLY_EXIT
            if (__all(C == 0.0f)) done = true;
#endif
        }
#if SB_EARLY_EXIT
        if (lane == 0) flags[buf * NW + wid] = done ? 1u : 0u;
#endif
        if (j > 0) { VM_WAIT(); SWRITE(buf ^ 1); }
        __syncthreads();
        if (j == 0) break;
#if SB_EARLY_EXIT
        { unsigned nd = 0;
#pragma unroll
          for (int w = 0; w < NW; ++w) nd += flags[buf * NW + w];
          if (nd == (unsigned)NW) break; }
#endif
    }
#undef SLOAD
#undef SWRITE
    LAS bf16* stg = (LAS bf16*)(lds + LDS_OST + wid * 8192);
#pragma unroll
    for (int r = 0; r < 16; ++r) { const int orow = crow(r, hi);
#pragma unroll
        for (int d0 = 0; d0 < 4; ++d0) { const unsigned w = cvtpk(o[d0][r], 0.f); stg[orow * HD + d0 * 32 + r32] = (bf16)(w & 0xffffu); } }
    LDS_WAIT(); asm volatile("" ::: "memory");
#pragma unroll
    for (int i = 0; i < 8; ++i) { const int row = i * 4 + (lane >> 4), ch = lane & 15;
        const v4u v = *(const LAS v4u*)(stg + row * HD + ch * 8);
        const size_t off = (size_t)(qlo + row) * PITCH + h * HD + ch * 8;
        const v4u g = *(const v4u*)(SG + off);
        v4u w; w.x = cvtpk(bflo(v.x) * bflo(g.x), bfhi(v.x) * bfhi(g.x)); w.y = cvtpk(bflo(v.y) * bflo(g.y), bfhi(v.y) * bfhi(g.y));
        w.z = cvtpk(bflo(v.z) * bflo(g.z), bfhi(v.z) * bfhi(g.z)); w.w = cvtpk(bflo(v.w) * bflo(g.w), bfhi(v.w) * bfhi(g.w));
        *(v4u*)(O + off) = w; }
    __syncthreads();
}
#undef KSWZ
#undef SBAR
}

struct Args { const float* in[13]; float* out; unsigned char* ws; };
typedef const __attribute__((address_space(4))) Args* KArgs;
#define PHASE_ARGS() KArgs ka = ka0; asm volatile("" : "+s"(ka)); unsigned char* const ws = ka->ws; (void)ws; \
    int tid = threadIdx.x; asm volatile("" : "+v"(tid)); const int lane = tid & 63, wave = __builtin_amdgcn_readfirstlane(tid >> 6); (void)lane; (void)wave; \
    const int G = gridDim.x, bx = blockIdx.x, gw = bx * NWAVES + wave, NGW = G * NWAVES; (void)gw; (void)NGW
__global__ void __launch_bounds__(NWAVES * 64, 2) yoco_fwd(Args args_unused) {
    extern __shared__ __attribute__((aligned(16))) unsigned char lds_raw[];
    LAS unsigned char* lds = (LAS unsigned char*)lds_raw;
    const KArgs ka0 = (KArgs)__builtin_amdgcn_kernarg_segment_ptr();
    XcdBarrier bar;
    {
        volatile LAS unsigned* MISC = (volatile LAS unsigned*)(lds + MISC_OFF);
        for (int u = threadIdx.x; u < (LDS_BYTES - LDSCTL_OFF) / 4; u += NWAVES * 64) ((LAS unsigned*)(lds + LDSCTL_OFF))[u] = 0u;
        __syncthreads();
        bar = xcd_barrier_post((unsigned*)(ka0->ws + WS_CTL) + CW_BAR, MISC + 8);
    }
#define GRID_BAR() xcd_barrier(bar)

    {
        PHASE_ARGS();
        const float* a_pre = ka->in[1]; const float* a_w_in = ka->in[2]; const float* a_w_group = ka->in[3]; const float* a_scale = ka->in[4];
        const float* a_w_out = ka->in[5]; const float* kv_norm = ka->in[7]; const float* w_kv = ka->in[8];
        const float* b_pre = ka->in[9]; const float* b_w_in = ka->in[10]; const float* b_w_out = ka->in[11];
        bf16* WAIN = (bf16*)(ws + WS_WAIN); bf16* WAG = (bf16*)(ws + WS_WAG); bf16* WAOUT = (bf16*)(ws + WS_WAOUT); bf16* WKVQ = (bf16*)(ws + WS_WKVQ);
        bf16* WBIN1 = (bf16*)(ws + WS_WBIN1); bf16* WBOUT = (bf16*)(ws + WS_WBOUT);
        LAS unsigned char* scr = lds + RING_OFF + wave * 8192;
        constexpr int I_IN = (DM / 64) * (2 * DM / 64);
        constexpr int I_G = (1024 / 64) * (1024 / 64);
        constexpr int I_OUT = (DM / 64) * (DM / 64);
        constexpr int NITEMS = 2 * I_IN + 8 * I_G + 2 * I_OUT + I_IN + 2 * I_IN + 2 * I_OUT;
        for (int it = gw; it < NITEMS; it += NGW) {
            int r = it;
            if (r < 2 * I_IN) { const int l = r / I_IN; r -= l * I_IN; transpose_item(a_w_in + (size_t)l * DM * 2 * DM, DM, 2 * DM, WAIN + (size_t)l * 2 * DM * DM, DM, 0, a_pre + l * DM, nullptr, scr, r, lane); continue; } r -= 2 * I_IN;
            if (r < 8 * I_G) { const int lg = r / I_G; r -= lg * I_G; const int l = lg >> 2, gq = lg & 3;
                transpose_item(a_w_group + (size_t)lg * 1024 * 1024, 1024, 1024, WAG + (size_t)l * DM * 1024, 1024, gq * 1024, nullptr, a_scale + l * DM + gq * 1024, scr, r, lane); continue; } r -= 8 * I_G;
            if (r < 2 * I_OUT) { const int l = r / I_OUT; r -= l * I_OUT; transpose_item(a_w_out + (size_t)l * DM * DM, DM, DM, WAOUT + (size_t)l * DM * DM, DM, 0, nullptr, nullptr, scr, r, lane); continue; } r -= 2 * I_OUT;
            if (r < I_IN) { transpose_item(w_kv, DM, 2 * DM, WKVQ, DM, 0, kv_norm, nullptr, scr, r, lane); continue; } r -= I_IN;
            if (r < I_IN) { transpose_item(b_w_in, DM, 2 * DM, WKVQ, DM, 2 * DM, b_pre, nullptr, scr, r, lane); continue; } r -= I_IN;
            if (r < I_IN) { transpose_item(b_w_in + (size_t)DM * 2 * DM, DM, 2 * DM, WBIN1, DM, 0, b_pre + DM, nullptr, scr, r, lane); continue; } r -= I_IN;
            { const int l = r / I_OUT; r -= l * I_OUT; transpose_item(b_w_out + (size_t)l * DM * DM, DM, DM, WBOUT + (size_t)l * DM * DM, DM, 0, nullptr, nullptr, scr, r, lane); }
        }
        const float* x_in = ka->in[0]; bf16* HB = (bf16*)(ws + WS_HB);
        for (int m = gw; m < S; m += NGW) rms_row_to_bf16(x_in + (size_t)m * DM, HB + (size_t)m * DM, lane);
    }
    GRID_BAR();

    for (int l = 0; l < 2; ++l) {
        {
            PHASE_ARGS();
            pg8::Gemm g{(const bf16*)(ws + WS_HB), (const bf16*)(ws + WS_WAIN) + (size_t)l * 2 * DM * DM, S, 2 * DM, DM, DM, DM, 1 << 20}; pg8::StaticOrder So; So.init(S, 2 * DM, G, bx);
            pg8::EpiSeg<false> E{(bf16*)(ws + WS_U), -1, 1, 1.f, nullptr};
            pg8::gemm_phase<pg8::EpiSeg<false>, pg8::StaticOrder, PG8_ALIGN, PG8_SP2>(lds + RING_OFF, g, So, E);
        }
        GRID_BAR();
        {   PHASE_ARGS();
            for (int rb = bx; rb < S / 32; rb += G) pool_block((const bf16*)(ws + WS_U), (bf16*)(ws + WS_PO), rb, tid);
        }
        GRID_BAR();
        {
            PHASE_ARGS();
            pg8::Gemm g{(const bf16*)(ws + WS_PO), (const bf16*)(ws + WS_WAG) + (size_t)l * DM * 1024, S, DM, 1024, DM, 1024, 4}; pg8::StaticOrder So; So.init(S, DM, G, bx);
            pg8::EpiSeg<true> E{(bf16*)(ws + WS_U), -1, -1, 1.f, (const bf16*)(ws + WS_SG)};
            pg8::gemm_phase<pg8::EpiSeg<true>, pg8::StaticOrder, PG8_ALIGN, PG8_SP2>(lds + RING_OFF, g, So, E);
        }
        GRID_BAR();
        {
            PHASE_ARGS();
            pg8::Gemm g{(const bf16*)(ws + WS_U), (const bf16*)(ws + WS_WAOUT) + (size_t)l * DM * DM, S, DM, DM, DM, DM, 1 << 20}; pg8::StaticOrder So; So.init(S, DM, G, bx);
            pg8::EpiF32 E{(float*)(ws + WS_Y), DM};
            pg8::gemm_phase<pg8::EpiF32, pg8::StaticOrder, PG8_ALIGN, PG8_SP2>(lds + RING_OFF, g, So, E);
        }
        GRID_BAR();
        {
            PHASE_ARGS();
            float* xres = ka->out; const float* xs = (l == 0) ? ka->in[0] : (const float*)xres; const float* gp = ka->in[6] + l * DM;
            const float* YB = (const float*)(ws + WS_Y); bf16* HB = (bf16*)(ws + WS_HB);
            for (int m = gw; m < S; m += NGW) norm_res_row(xs + (size_t)m * DM, YB + (size_t)m * DM, gp, xres + (size_t)m * DM, HB + (size_t)m * DM, lane);
        }
        GRID_BAR();
    }

    for (int jl = 0; jl < 2; ++jl) {
        {
            PHASE_ARGS();
            const int N = (jl == 0) ? 4 * DM : 2 * DM;
            pg8::Gemm g{(const bf16*)(ws + WS_HB), (const bf16*)(ws + ((jl == 0) ? WS_WKVQ : WS_WBIN1)), S, N, DM, DM, DM, 1 << 20}; pg8::StaticOrder So; So.init(S, N, G, bx);
            pg8::EpiSeg<false> E{(bf16*)(ws + ((jl == 0) ? WS_K : WS_U)), (jl == 0) ? 2 : 0, (jl == 0) ? 3 : 1, QSCALE, nullptr};
            pg8::gemm_phase<pg8::EpiSeg<false>, pg8::StaticOrder, PG8_ALIGN, PG8_SP2>(lds + RING_OFF, g, So, E);
        }
        GRID_BAR();
        {
            PHASE_ARGS();
            bf16* UB = (bf16*)(ws + WS_U); const bf16* KB = (const bf16*)(ws + WS_K); const bf16* VB = (const bf16*)(ws + WS_V); const bf16* SGB = (const bf16*)(ws + WS_SG);
            for (int i = bx; i < 512; i += G) { const int xcd = i & 7, k = i >> 3, h = xcd + 8 * (k >> 4), pr = k & 15;
                for (int half = 0; half < 2; ++half) sb::attn_unit(h, half ? pr : 31 - pr, UB, KB, VB, SGB, UB, (LAS char*)(lds + RING_OFF)); }
        }
        GRID_BAR();
        {
            PHASE_ARGS();
            pg8::Gemm g{(const bf16*)(ws + WS_U), (const bf16*)(ws + WS_WBOUT) + (size_t)jl * DM * DM, S, DM, DM, DM, DM, 1 << 20}; pg8::StaticOrder So; So.init(S, DM, G, bx);
            pg8::EpiF32 E{(float*)(ws + WS_Y), DM};
            pg8::gemm_phase<pg8::EpiF32, pg8::StaticOrder, PG8_ALIGN, PG8_SP2>(lds + RING_OFF, g, So, E);
        }
        GRID_BAR();
        {
            PHASE_ARGS();
            float* xres = ka->out; const float* gp = ka->in[12] + jl * DM; const float* YB = (const float*)(ws + WS_Y); bf16* HB = (bf16*)(ws + WS_HB);
            for (int m = gw; m < S; m += NGW) norm_res_row(xres + (size_t)m * DM, YB + (size_t)m * DM, gp, xres + (size_t)m * DM, (jl == 0) ? HB + (size_t)m * DM : (bf16*)nullptr, lane);
        }
        if (jl == 0) GRID_BAR();
    }
#undef GRID_BAR
}

extern "C" void kernel_launch(void* const* d_in, const int* in_sizes, int n_in, void* d_out, int out_size, void* d_ws, size_t ws_size, hipStream_t stream) {
    static int grid = 0;
    if (grid == 0) {
        if (n_in != 13 || in_sizes[0] != S * DM || out_size != S * DM || ws_size < WS_END) {
            fprintf(stderr, "kernel_launch: unexpected shapes (n_in %d, in0 %d, out %d, ws %zu); nothing launched\n", n_in, n_in > 0 ? in_sizes[0] : -1, out_size, ws_size); grid = -1; return; }
        int dev = 0, cus = 0, per_cu = 0;
        if (hipGetDevice(&dev) != hipSuccess || hipDeviceGetAttribute(&cus, hipDeviceAttributeMultiprocessorCount, dev) != hipSuccess) { fprintf(stderr, "kernel_launch: device query failed\n"); grid = -1; return; }
        if (hipFuncSetAttribute((const void*)yoco_fwd, hipFuncAttributeMaxDynamicSharedMemorySize, LDS_BYTES) != hipSuccess) { fprintf(stderr, "kernel_launch: hipFuncSetAttribute failed\n"); grid = -1; return; }
        if (hipOccupancyMaxActiveBlocksPerMultiprocessor(&per_cu, (const void*)yoco_fwd, NWAVES * 64, LDS_BYTES) != hipSuccess || per_cu < 1)
            fprintf(stderr, "kernel_launch: note: occupancy query reports %d workgroups per CU\n", per_cu);
        (void)hipGetLastError();
        grid = cus;
    }
    if (grid < 0) return;
    if (hipMemsetAsync((char*)d_ws + WS_CTL, 0, CTL_ZERO_BYTES, stream) != hipSuccess) { fprintf(stderr, "kernel_launch: memset failed\n"); return; }
    Args a{};
    for (int i = 0; i < 13; ++i) a.in[i] = (const float*)d_in[i];
    a.out = (float*)d_out; a.ws = (unsigned char*)d_ws;
    hipLaunchKernelGGL(yoco_fwd, dim3(grid), dim3(NWAVES * 64), LDS_BYTES, stream, a);
    const hipError_t le = hipPeekAtLastError();
    if (le != hipSuccess) fprintf(stderr, "kernel_launch: launch failed: %s\n", hipGetErrorName(le));
}
```

```cpp
#include <hip/hip_runtime.h>
#include <cstdio>
#include <cstdint>

#ifndef SB_EARLY_EXIT
#define SB_EARLY_EXIT 1
#endif

namespace pg8 {
#define PG8_LAS __attribute__((address_space(3)))
typedef unsigned short bf16_t;
typedef short bf16x8 __attribute__((ext_vector_type(8)));
typedef float f32x4 __attribute__((ext_vector_type(4)));
typedef unsigned u32x4 __attribute__((ext_vector_type(4)));
constexpr int BM = 256, BK = 64, HALF = 128, HTB = HALF * BK * 2  , STAGE_BYTES = 8 * HTB, NXCD = 8, WGM = 8;

__host__ __device__ __forceinline__ int lds_byte(int r, int c) { const int st = (r >> 4) * 2 + (c >> 5), rr = r & 15, cc = c & 31, ob = rr * 64 + cc * 2; return st * 1024 + (ob ^ (((ob >> 9) & 1) << 5)); }
__host__ __device__ __forceinline__ void stage_rc(int b, int& R, int& C) { const int st = b / 1024, sb = b % 1024, swz = sb ^ (((sb >> 9) & 1) << 5); R = (st >> 1) * 16 + swz / 64; C = (st & 1) * 32 + (swz % 64) / 2; }
__host__ __device__ __forceinline__ int perm32(int rho) { const int n = rho >> 4, i = rho & 15; return 8 * (i >> 2) + 4 * n + (i & 3); }

struct Unit { int pm, pn; };
struct Gemm { const bf16_t* A; const bf16_t* Bt; int M, N, K, lda, ldb, agdiv, bgdiv; };

struct StaticOrder {
    int nM, nN, nwg, G, c;
    __host__ __device__ void init(int M, int N, int G_, int c_) { nM = M / BM; nN = N / BM; nwg = nM * nN; G = G_; c = c_; }
    __host__ __device__ bool next(int i, Unit& u) const {
        const long L = (long)i * G + c; if (L >= nwg) return false;
        int wgid = (int)L; { const int q = nwg / NXCD, r = nwg % NXCD, xcd = wgid % NXCD, off = wgid / NXCD; wgid = (xcd < r ? xcd * (q + 1) : r * (q + 1) + (xcd - r) * q) + off; }
        const int nig = WGM * nN, gid = wgid / nig, fm = gid * WGM, gsz = (nM - fm) < WGM ? (nM - fm) : WGM;
        u.pm = fm + ((wgid % nig) % gsz); u.pn = (wgid % nig) / gsz; return true;
    }
    __device__ __forceinline__ void a_ready(const Unit&) const {}
    __device__ __forceinline__ void done(const Unit&) const {}
};

__device__ __forceinline__ unsigned cvt_pk_bf16(float lo, float hi) { unsigned r; asm volatile("v_cvt_pk_bf16_f32 %0, %1, %2" : "=v"(r) : "v"(lo), "v"(hi)); return r; }
__device__ __forceinline__ float bf_lo(unsigned w) { return __uint_as_float(w << 16); }
__device__ __forceinline__ float bf_hi(unsigned w) { return __uint_as_float(w & 0xffff0000u); }
__device__ __forceinline__ float silu_f(float v) { const float e = __builtin_amdgcn_exp2f(v * -1.4426950408889634f); return v * __builtin_amdgcn_rcpf(1.0f + e); }

struct EpiF32 {
    static constexpr bool PERM = false, AFTER_DRAIN = false;
    float* C; int ldc;
    __device__ __forceinline__ void operator()(const f32x4 (&acc)[2][2][4][2], const Unit& u, int wr, int wc, int fr, int fq) const {
        const int row0 = u.pm * BM + wr * 64 + fr, col0 = u.pn * BM + wc * 32 + 4 * fq;
#pragma unroll
        for (int ai = 0; ai < 2; ++ai)
#pragma unroll
            for (int m = 0; m < 4; ++m) { float* rowp = C + (size_t)(row0 + ai * HALF + m * 16) * ldc + col0;
#pragma unroll
                for (int bj = 0; bj < 2; ++bj)
#pragma unroll
                    for (int n = 0; n < 2; ++n) *(f32x4*)(rowp + bj * HALF + n * 16) = acc[ai][bj][m][n]; }
    }
};
template <bool HAS_MUL> struct EpiSeg {
    static constexpr bool PERM = true, AFTER_DRAIN = false;
    static constexpr size_t SEG_ELEMS = (size_t)8192 * 4096;
    bf16_t* d; int qseg, gseg; float qscale; const bf16_t* mul; int rsplit, rjump;
    __device__ __forceinline__ void operator()(const f32x4 (&acc)[2][2][4][2], const Unit& u, int wr, int wc, int fr, int fq) const {
        const int row0 = u.pm * BM + ((u.pm * BM >= rsplit) ? rjump : 0) + wr * 64 + fr; int colt = u.pn * BM; const int seg = colt >> 12; colt &= 4095;
        bf16_t* base = d + (size_t)seg * SEG_ELEMS; const float sc = (seg == qseg) ? qscale : 1.0f;
        const bool silu = (seg == gseg);
        const int col0 = colt + wc * 32 + 8 * fq;
#pragma unroll
        for (int ai = 0; ai < 2; ++ai)
#pragma unroll
            for (int m = 0; m < 4; ++m) { const size_t off = (size_t)(row0 + ai * HALF + m * 16) * 4096 + col0;
#pragma unroll
                for (int bj = 0; bj < 2; ++bj) { f32x4 v0 = acc[ai][bj][m][0] * sc, v1 = acc[ai][bj][m][1] * sc;
                    if (silu) {
#pragma unroll
                        for (int j = 0; j < 4; ++j) { v0[j] = silu_f(v0[j]); v1[j] = silu_f(v1[j]); } }
                    if (HAS_MUL) { const u32x4 g = *(const u32x4*)(mul + off + bj * HALF);
                        v0[0] *= bf_lo(g.x); v0[1] *= bf_hi(g.x); v0[2] *= bf_lo(g.y); v0[3] *= bf_hi(g.y); v1[0] *= bf_lo(g.z); v1[1] *= bf_hi(g.z); v1[2] *= bf_lo(g.w); v1[3] *= bf_hi(g.w); }
                    u32x4 w; w.x = cvt_pk_bf16(v0[0], v0[1]); w.y = cvt_pk_bf16(v0[2], v0[3]); w.z = cvt_pk_bf16(v1[0], v1[1]); w.w = cvt_pk_bf16(v1[2], v1[3]);
                    *(u32x4*)(base + off + bj * HALF) = w; } }
    }
};

template <class Epi, class Sched, bool ALIGN_EPI = false, bool SP2 = false>
__device__ __forceinline__ void gemm_phase(PG8_LAS unsigned char* lds, const Gemm g, const Sched& S, const Epi& E) {
    int tid = threadIdx.x; asm volatile("" : "+v"(tid));
    const int wid = __builtin_amdgcn_readfirstlane(tid >> 6), lane = tid & 63, wr = wid >> 2, wc = wid & 3, fr = lane & 15, fq = lane >> 4;
    const int K = g.K, nt = K / BK;
    unsigned voffA[2], voffB[2];
#pragma unroll
    for (int i = 0; i < 2; ++i) { int R, C; stage_rc(tid * 16 + i * 8192, R, C); const int Rb = Epi::PERM ? ((R & ~31) + perm32(R & 31)) : R;
        voffA[i] = (unsigned)(R * g.lda + C) * 2u; voffB[i] = (unsigned)(Rb * g.ldb + C) * 2u; }
    const size_t kstep = (size_t)(BK * 2);
    const size_t hstepA = (size_t)HALF * g.lda * 2, hstepB = (size_t)HALF * g.ldb * 2;
    const size_t tstepA = 2 * hstepA, tstepB = 2 * hstepB;
    const unsigned ldsw = (unsigned)wid * 1024u;
    const int aoff = lds_byte(wr * 64 + fr, fq * 8), boff = lds_byte(wc * 32 + fr, fq * 8);
#define PG8_SA(b, h) (((b) * 2 + (h)) * HTB)
#define PG8_SB(b, h) ((4 + (b) * 2 + (h)) * HTB)
#define PG8_STAGE(bufoff, gbase, voff) do { _Pragma("unroll") for (int _i = 0; _i < 2; ++_i) \
        __builtin_amdgcn_global_load_lds((const unsigned*)((const char*)(gbase) + (voff)[_i]), (PG8_LAS unsigned*)(lds + (bufoff) + ldsw + _i * 8192), 16, 0, 0); } while (0)
#define PG8_LDA(dst, b, h) do { _Pragma("unroll") for (int m = 0; m < 4; ++m) _Pragma("unroll") for (int k = 0; k < 2; ++k) dst[m][k] = *(const PG8_LAS bf16x8*)(lds + PG8_SA(b, h) + aoff + m * 2048 + k * 1024); } while (0)
#define PG8_LDB(dst, b, h) do { _Pragma("unroll") for (int n = 0; n < 2; ++n) _Pragma("unroll") for (int k = 0; k < 2; ++k) dst[n][k] = *(const PG8_LAS bf16x8*)(lds + PG8_SB(b, h) + boff + n * 2048 + k * 1024); } while (0)
#define PG8_MMA(ai, bj, At, Bt) do { __builtin_amdgcn_s_setprio(1); _Pragma("unroll") for (int m = 0; m < 4; ++m) _Pragma("unroll") for (int n = 0; n < 2; ++n) _Pragma("unroll") for (int k = 0; k < 2; ++k) \
        acc[ai][bj][m][n] = __builtin_amdgcn_mfma_f32_16x16x32_bf16(Bt[n][k], At[m][k], acc[ai][bj][m][n], 0, 0, 0); __builtin_amdgcn_s_setprio(0); } while (0)
#define PG8_WAIT_V(n) asm volatile("s_waitcnt vmcnt(" #n ")" ::: "memory")
#define PG8_WAIT_L(n) asm volatile("s_waitcnt lgkmcnt(" #n ")" ::: "memory")
#define PG8_BAR __builtin_amdgcn_s_barrier()
#define PG8_SCHED __builtin_amdgcn_sched_barrier(0)
#define PG8_ABASE(u) ((const char*)g.A + (size_t)(u).pm * tstepA + (size_t)((u).pn / g.agdiv) * (size_t)K * 2)
#define PG8_BBASE(u) ((const char*)g.Bt + (size_t)(u).pn * tstepB + (size_t)((u).pm / g.bgdiv) * (size_t)K * 2)
    Unit cur, nxt; int ui = 0;
    if (!S.next(0, cur)) return;
    f32x4 acc[2][2][4][2];
#pragma unroll
    for (int a = 0; a < 2; ++a)
#pragma unroll
        for (int b = 0; b < 2; ++b)
#pragma unroll
            for (int m = 0; m < 4; ++m)
#pragma unroll
                for (int n = 0; n < 2; ++n) acc[a][b][m][n] = (f32x4){0.f, 0.f, 0.f, 0.f};
    bf16x8 At[4][2], B0[2][2], B1[2][2];
    const char* cA = PG8_ABASE(cur); const char* cB = PG8_BBASE(cur);
    S.a_ready(cur);
    if constexpr (SP2) {
        PG8_STAGE(PG8_SB(0, 0), cB, voffB); PG8_STAGE(PG8_SB(0, 1), cB + hstepB, voffB); PG8_STAGE(PG8_SA(0, 0), cA, voffA); PG8_STAGE(PG8_SA(0, 1), cA + hstepA, voffA);
        if (wr == 1) PG8_BAR;
        PG8_WAIT_V(2); PG8_BAR;
        PG8_STAGE(PG8_SB(1, 0), cB + kstep, voffB); PG8_STAGE(PG8_SA(1, 0), cA + kstep, voffA); PG8_STAGE(PG8_SB(1, 1), cB + hstepB + kstep, voffB);
        PG8_WAIT_V(6); PG8_BAR;
    } else {
        PG8_STAGE(PG8_SB(0, 0), cB, voffB); PG8_STAGE(PG8_SA(0, 0), cA, voffA); PG8_STAGE(PG8_SB(0, 1), cB + hstepB, voffB); PG8_STAGE(PG8_SA(0, 1), cA + hstepA, voffA);
        if (wr == 1) PG8_BAR;
        PG8_WAIT_V(4); PG8_BAR;
        PG8_STAGE(PG8_SB(1, 0), cB + kstep, voffB); PG8_STAGE(PG8_SA(1, 0), cA + kstep, voffA); PG8_STAGE(PG8_SB(1, 1), cB + hstepB + kstep, voffB);
        PG8_WAIT_V(6); PG8_BAR;
    }
    for (;;) {
        const bool has_next = S.next(ui + 1, nxt);
        const char* nA = has_next ? PG8_ABASE(nxt) : cA; const char* nB = has_next ? PG8_BBASE(nxt) : cB;
        for (int t = 0; t < nt; t += 2) {
            const bool last = (t == nt - 2);
            const char* a1 = cA + (size_t)(t + 1) * kstep;
            const char* a2 = last ? nA : cA + (size_t)(t + 2) * kstep; const char* b2 = last ? nB : cB + (size_t)(t + 2) * kstep;
            const char* a3 = a2 + kstep; const char* b3 = b2 + kstep;
            if (last && has_next) S.a_ready(nxt);
            if constexpr (SP2) {
            PG8_LDB(B0, 0, 0); PG8_LDB(B1, 0, 1); PG8_SCHED; PG8_LDA(At, 0, 0); PG8_STAGE(PG8_SA(1, 1), a1 + hstepA, voffA);
            PG8_WAIT_V(8); PG8_WAIT_L(0); PG8_BAR; PG8_MMA(0, 0, At, B0); PG8_MMA(0, 1, At, B1); PG8_BAR; PG8_SCHED;
            PG8_LDA(At, 0, 1); PG8_STAGE(PG8_SB(0, 0), b2, voffB); PG8_STAGE(PG8_SB(0, 1), b2 + hstepB, voffB); PG8_STAGE(PG8_SA(0, 0), a2, voffA);
            PG8_WAIT_V(8); PG8_WAIT_L(0); PG8_BAR; PG8_MMA(1, 0, At, B0); PG8_MMA(1, 1, At, B1); PG8_BAR; PG8_SCHED;
            PG8_LDB(B0, 1, 0); PG8_LDB(B1, 1, 1); PG8_SCHED; PG8_LDA(At, 1, 0); PG8_STAGE(PG8_SA(0, 1), a2 + hstepA, voffA);
            PG8_WAIT_V(8); PG8_WAIT_L(0); PG8_BAR; PG8_MMA(0, 0, At, B0); PG8_MMA(0, 1, At, B1); PG8_BAR; PG8_SCHED;
            PG8_LDA(At, 1, 1); PG8_STAGE(PG8_SB(1, 0), b3, voffB); PG8_STAGE(PG8_SB(1, 1), b3 + hstepB, voffB); PG8_STAGE(PG8_SA(1, 0), a3, voffA);
            PG8_WAIT_V(8); PG8_WAIT_L(0); PG8_BAR; PG8_MMA(1, 0, At, B0); PG8_MMA(1, 1, At, B1); PG8_BAR; PG8_SCHED;
            } else {
            PG8_LDB(B0, 0, 0); PG8_SCHED; PG8_LDA(At, 0, 0); PG8_STAGE(PG8_SA(1, 1), a1 + hstepA, voffA);
            PG8_WAIT_L(8); PG8_BAR; PG8_WAIT_L(0); PG8_MMA(0, 0, At, B0); PG8_BAR; PG8_SCHED;
            PG8_LDB(B1, 0, 1); PG8_STAGE(PG8_SB(0, 0), b2, voffB);
            PG8_BAR; PG8_WAIT_L(0); PG8_MMA(0, 1, At, B1); PG8_BAR;
            PG8_LDA(At, 0, 1); PG8_STAGE(PG8_SA(0, 0), a2, voffA);
            PG8_BAR; PG8_WAIT_L(0); PG8_MMA(1, 0, At, B0); PG8_BAR; PG8_SCHED;
            PG8_STAGE(PG8_SB(0, 1), b2 + hstepB, voffB);
            PG8_WAIT_V(6); PG8_BAR; PG8_MMA(1, 1, At, B1); PG8_BAR;
            PG8_LDB(B0, 1, 0); PG8_SCHED; PG8_LDA(At, 1, 0); PG8_STAGE(PG8_SA(0, 1), a2 + hstepA, voffA);
            PG8_WAIT_L(8); PG8_BAR; PG8_WAIT_L(0); PG8_MMA(0, 0, At, B0); PG8_BAR; PG8_SCHED;
            PG8_LDB(B1, 1, 1); PG8_STAGE(PG8_SB(1, 0), b3, voffB);
            PG8_BAR; PG8_WAIT_L(0); PG8_MMA(0, 1, At, B1); PG8_BAR;
            PG8_LDA(At, 1, 1); PG8_STAGE(PG8_SA(1, 0), a3, voffA);
            PG8_BAR; PG8_WAIT_L(0); PG8_MMA(1, 0, At, B0); PG8_BAR; PG8_SCHED;
            PG8_STAGE(PG8_SB(1, 1), b3 + hstepB, voffB);
            PG8_WAIT_V(6); PG8_BAR; PG8_MMA(1, 1, At, B1); PG8_BAR;
            }
        }
        if constexpr (ALIGN_EPI) { if (wr == 0) PG8_BAR; }
        E(acc, cur, wr, wc, fr, fq); S.done(cur);
        if (!has_next) break;
#pragma unroll
        for (int a = 0; a < 2; ++a)
#pragma unroll
            for (int b = 0; b < 2; ++b)
#pragma unroll
                for (int m = 0; m < 4; ++m)
#pragma unroll
                    for (int n = 0; n < 2; ++n) acc[a][b][m][n] = (f32x4){0.f, 0.f, 0.f, 0.f};
        cur = nxt; cA = nA; cB = nB; ++ui;
        if constexpr (ALIGN_EPI) { if (wr == 1) PG8_BAR; }
    }
    PG8_WAIT_V(0);
    if constexpr (!ALIGN_EPI) { if (wr == 0) PG8_BAR; }
    PG8_BAR;
#undef PG8_SA
#undef PG8_SB
#undef PG8_STAGE
#undef PG8_LDA
#undef PG8_LDB
#undef PG8_MMA
#undef PG8_WAIT_V
#undef PG8_WAIT_L
#undef PG8_BAR
#undef PG8_SCHED
#undef PG8_ABASE
#undef PG8_BBASE
}
}

#ifndef PG8_SP2
#define PG8_SP2 true
#endif
#ifndef PG8_ALIGN
#define PG8_ALIGN true
#endif

#define GAS __attribute__((address_space(1)))
#define LAS __attribute__((address_space(3)))
typedef unsigned short bf16;
typedef unsigned v4u __attribute__((ext_vector_type(4)));
typedef unsigned v2u __attribute__((ext_vector_type(2)));
typedef float f32x4 __attribute__((ext_vector_type(4)));
typedef short bf16x8 __attribute__((ext_vector_type(8)));
typedef short s16x4 __attribute__((ext_vector_type(4)));
typedef float f32x16 __attribute__((ext_vector_type(16)));
typedef GAS unsigned gu32;
#define RLX_AGENT __ATOMIC_RELAXED, __HIP_MEMORY_SCOPE_AGENT
#define LDS_WAIT() asm volatile("s_waitcnt lgkmcnt(0)" ::: "memory")
#define VM_WAIT() asm volatile("s_waitcnt vmcnt(0)" ::: "memory")
__device__ __forceinline__ unsigned cvtpk(float lo, float hi) { unsigned r; asm volatile("v_cvt_pk_bf16_f32 %0, %1, %2" : "=v"(r) : "v"(lo), "v"(hi)); return r; }
__device__ __forceinline__ float bflo(unsigned w) { return __uint_as_float(w << 16); }
__device__ __forceinline__ float bfhi(unsigned w) { return __uint_as_float(w & 0xffff0000u); }

#define XB_TMO      128
#define XB_XCNT(j)  (256  + 64 * (j))
#define XB_XSUB(j)  (1280 + 64 * (j))
#define XB_XGEN(j)  (2304 + 64 * (j))
#define XB_TOP      3328
#define XB_TOPGEN   3392
#define XCD_BAR_WORDS 3456
#define XB_SPIN_CAP (1u << 18)

__device__ __forceinline__ unsigned xb_ld(unsigned* p)              { return __hip_atomic_load(p, __ATOMIC_RELAXED, __HIP_MEMORY_SCOPE_AGENT); }
__device__ __forceinline__ unsigned xb_add(unsigned* p, unsigned v) { return __hip_atomic_fetch_add(p, v, __ATOMIC_RELAXED, __HIP_MEMORY_SCOPE_AGENT); }
__device__ __forceinline__ unsigned xb_xcc_id() { return (unsigned)__builtin_amdgcn_s_getreg((3 << 11) | 20) & 0xFu; }
#define XB_SPIN(cond, bar) do { unsigned _sp = 0; while (cond) { __builtin_amdgcn_s_sleep(1); \
    if ((++_sp & 255u) == 0u) { if (xb_ld(&(bar)[XB_TMO])) break; if (_sp > XB_SPIN_CAP) { atomicAdd(&(bar)[XB_TMO], 1u); break; } } } } while (0)

struct XcdBarrier {
    unsigned* bar; unsigned x;
    volatile LAS unsigned* st;
};
__device__ __forceinline__ XcdBarrier xcd_barrier_post(unsigned* bar, volatile LAS unsigned* st) {
    XcdBarrier b; b.bar = bar; b.x = xb_xcc_id(); b.st = st;
    if (threadIdx.x == 0) (void)xb_add(&bar[XB_XCNT(b.x)], 1u);
    return b;
}
__device__ __forceinline__ void xcd_barrier_complete(unsigned* bar, unsigned x, unsigned& nloc, unsigned& nx) {
    const unsigned G = gridDim.x * gridDim.y * gridDim.z;
    unsigned sum, cnt, mine, sp = 0u;
    for (;;) {
        sum = 0u; cnt = 0u; mine = 0u;
#pragma unroll
        for (unsigned j = 0; j < 16; ++j) { const unsigned c = xb_ld(&bar[XB_XCNT(j)]); sum += c; cnt += (c > 0u) ? 1u : 0u; mine = (j == x) ? c : mine; }
        if (sum == G) break;
        __builtin_amdgcn_s_sleep(1);
        if ((++sp & 255u) == 0u) { if (xb_ld(&bar[XB_TMO])) break; if (sp > XB_SPIN_CAP) { atomicAdd(&bar[XB_TMO], 1u); break; } }
    }
    nloc = mine > 0u ? mine : 1u; nx = cnt > 0u ? cnt : 1u;
}
__device__ __forceinline__ void xcd_barrier(const XcdBarrier& b) {
    asm volatile("s_waitcnt vmcnt(0)" ::: "memory");
    __syncthreads();
    if (threadIdx.x == 0) {
        unsigned* bar = b.bar;
        __builtin_amdgcn_s_waitcnt(0);
        unsigned nloc = b.st[0], nx = b.st[1];
        if (nloc == 0u) { xcd_barrier_complete(bar, b.x, nloc, nx); b.st[0] = nloc; b.st[1] = nx; }
        const unsigned old = xb_add(&bar[XB_XSUB(b.x)], 1u);
        const unsigned gen = old / nloc;
        if (old + 1u == (gen + 1u) * nloc) {
            __builtin_amdgcn_fence(__ATOMIC_RELEASE, "agent");
            asm volatile("s_waitcnt vmcnt(0)" ::: "memory");
            const unsigned og = xb_add(&bar[XB_TOP], 1u);
            const unsigned tg = og / nx;
            if (og + 1u == (tg + 1u) * nx) xb_add(&bar[XB_TOPGEN], 1u);
            else XB_SPIN(xb_ld(&bar[XB_TOPGEN]) == tg, bar);
            __builtin_amdgcn_fence(__ATOMIC_ACQUIRE, "agent");
            xb_add(&bar[XB_XGEN(b.x)], 1u);
            asm volatile("s_waitcnt vmcnt(0)" ::: "memory");
        } else {
            XB_SPIN(xb_ld(&bar[XB_XGEN(b.x)]) == gen, bar);
            __builtin_amdgcn_fence(__ATOMIC_ACQUIRE, "agent");
            asm volatile("s_waitcnt vmcnt(0)" ::: "memory");
        }
    }
    __syncthreads();
}

constexpr int NWAVES = 8;
constexpr int S = 8192, DM = 4096, NH = 32, HD = 128;
constexpr float RMS_EPS = 1e-6f;
constexpr float QSCALE = 0.08838834764831845f * 1.4426950408889634f;

constexpr size_t MiB = 1u << 20;
constexpr size_t WS_CTL = 0, CTL_ZERO_BYTES = 1 * MiB;
constexpr size_t WS_WAIN = 16 * MiB;
constexpr size_t WS_WAG = 144 * MiB;
constexpr size_t WS_WAOUT = 160 * MiB;
constexpr size_t WS_WKVQ = 224 * MiB;
constexpr size_t WS_WBIN1 = 352 * MiB;
constexpr size_t WS_WBOUT = 416 * MiB;
constexpr size_t WS_HB = 480 * MiB;
constexpr size_t WS_K = 544 * MiB;
constexpr size_t WS_V = 608 * MiB;
constexpr size_t WS_U = 672 * MiB;
constexpr size_t WS_SG = 736 * MiB;
constexpr size_t WS_PO = 800 * MiB;
constexpr size_t WS_Y = WS_SG;
constexpr size_t WS_END = 864 * MiB;
static_assert(WS_V == WS_K + 64 * MiB && WS_U == WS_V + 64 * MiB && WS_SG == WS_U + 64 * MiB && WS_PO == WS_SG + 64 * MiB, "EpiSeg segment layout");
constexpr size_t WS_RS = 512 * 1024;
constexpr int CW_BAR = 4096;
constexpr int CW_STEALQ = 8192;
constexpr int CW_DONE = 8256;

constexpr int RING_OFF = 0, RING_BYTES = 131072;
constexpr int LDSCTL_OFF = RING_BYTES, MISC_OFF = LDSCTL_OFF + 320;
constexpr int LDS_BYTES = 147456;
static_assert(MISC_OFF + 128 <= LDS_BYTES, "LDS map");

__device__ __forceinline__ float wave_sum(float v) {
#pragma unroll
    for (int o = 1; o < 64; o <<= 1) v += __shfl_xor(v, o);
    return v;
}

__device__ __forceinline__ void transpose_item(const float* __restrict__ W, int ldw, int N, bf16* __restrict__ WT, int ldt, int row_off, const float* __restrict__ gk, const float* __restrict__ gn,
                                               LAS unsigned char* scr, int item, int lane) {
    const int nblk = N >> 6, kb = item / nblk, nb = item - kb * nblk, k0 = kb << 6, n0 = nb << 6;
    const int nq = lane & 15, kr = lane >> 4;
    f32x4 va[8], vb[8];
#pragma unroll
    for (int i = 0; i < 8; ++i) { const int kp = 4 * i + kr; const float* p = W + (size_t)(k0 + 2 * kp) * ldw + n0 + 4 * nq; va[i] = __builtin_nontemporal_load((const f32x4*)p); vb[i] = __builtin_nontemporal_load((const f32x4*)(p + ldw)); }
    f32x4 gnv = (f32x4){1.f, 1.f, 1.f, 1.f}; if (gn) gnv = *(const f32x4*)(gn + n0 + 4 * nq);
    LAS unsigned* s32 = (LAS unsigned*)scr;
#pragma unroll
    for (int i = 0; i < 8; ++i) { const int kp = 4 * i + kr; float ga = 1.f, gb = 1.f; if (gk) { ga = gk[k0 + 2 * kp]; gb = gk[k0 + 2 * kp + 1]; }
        const f32x4 a = va[i] * ga * gnv, b = vb[i] * gb * gnv; const int wsw = kp ^ (4 * (nq & 7));
#pragma unroll
        for (int j = 0; j < 4; ++j) s32[(4 * nq + j) * 32 + wsw] = cvtpk(a[j], b[j]); }
    LDS_WAIT(); asm volatile("" ::: "memory");
    const int c = lane & 7;
#pragma unroll
    for (int pass = 0; pass < 8; ++pass) { const int n = (lane >> 3) + 8 * pass; const int ch = c ^ ((n >> 2) & 7);
        const v4u v = *(const LAS v4u*)(scr + n * 128 + ch * 16);
        __builtin_nontemporal_store(v, (v4u*)(WT + (size_t)(row_off + n0 + n) * ldt + k0 + 8 * c)); }
    LDS_WAIT(); asm volatile("" ::: "memory");
}
__device__ __forceinline__ void convert_row(const float* __restrict__ src, bf16* __restrict__ dst, float sc, int lane) {
    const f32x4* xr = (const f32x4*)src + 2 * lane; v4u* o8 = (v4u*)dst + lane; f32x4 v[16];
#pragma unroll
    for (int j = 0; j < 8; ++j) { v[2 * j] = xr[128 * j]; v[2 * j + 1] = xr[128 * j + 1]; }
#pragma unroll
    for (int j = 0; j < 8; ++j) { v4u w; w.x = cvtpk(v[2 * j].x * sc, v[2 * j].y * sc); w.y = cvtpk(v[2 * j].z * sc, v[2 * j].w * sc); w.z = cvtpk(v[2 * j + 1].x * sc, v[2 * j + 1].y * sc); w.w = cvtpk(v[2 * j + 1].z * sc, v[2 * j + 1].w * sc); o8[64 * j] = w; }
}
__device__ __forceinline__ void rms_row_to_bf16(const float* __restrict__ xrow, bf16* __restrict__ orow, float* __restrict__ rinv, int lane) {
    const f32x4* xr = (const f32x4*)xrow + lane;
    f32x4 v[16]; float s = 0.f;
#pragma unroll
    for (int j = 0; j < 16; ++j) { v[j] = xr[64 * j]; s += (v[j].x * v[j].x + v[j].y * v[j].y) + (v[j].z * v[j].z + v[j].w * v[j].w); }
    const float sd = sqrtf(wave_sum(s) * (1.f / DM) + RMS_EPS), rstd = 1.0f / sd;
    if (lane == 0) *rinv = sd;
    v2u* o8 = (v2u*)orow + lane;
#pragma unroll
    for (int j = 0; j < 16; ++j) { v2u w; w.x = cvtpk(v[j].x * rstd, v[j].y * rstd); w.y = cvtpk(v[j].z * rstd, v[j].w * rstd); o8[64 * j] = w; }
}
template <bool SRC_F32, bool OUT_F32>
__device__ __forceinline__ void norm_res_row(const float* __restrict__ xrow, bf16* hrow, float* rinv, const bf16* __restrict__ yrow, const float* __restrict__ g, float* __restrict__ xout, int lane) {
    const v4u* yr = (const v4u*)yrow + lane; const f32x4* gr = (const f32x4*)g + 2 * lane;
    v4u yw[8]; f32x4 x[16]; float s = 0.f;
#pragma unroll
    for (int j = 0; j < 8; ++j) yw[j] = yr[64 * j];
    if constexpr (SRC_F32) { const f32x4* xr = (const f32x4*)xrow + 2 * lane;
#pragma unroll
        for (int j = 0; j < 8; ++j) { x[2 * j] = xr[128 * j]; x[2 * j + 1] = xr[128 * j + 1]; } }
    else { const v4u* hr = (const v4u*)hrow + lane; v4u hw[8];
#pragma unroll
        for (int j = 0; j < 8; ++j) hw[j] = hr[64 * j];
        const float ri = *rinv;
#pragma unroll
        for (int j = 0; j < 8; ++j) { x[2 * j] = (f32x4){bflo(hw[j].x), bfhi(hw[j].x), bflo(hw[j].y), bfhi(hw[j].y)} * ri; x[2 * j + 1] = (f32x4){bflo(hw[j].z), bfhi(hw[j].z), bflo(hw[j].w), bfhi(hw[j].w)} * ri; } }
    f32x4 y[16];
#pragma unroll
    for (int j = 0; j < 8; ++j) { y[2 * j] = (f32x4){bflo(yw[j].x), bfhi(yw[j].x), bflo(yw[j].y), bfhi(yw[j].y)}; y[2 * j + 1] = (f32x4){bflo(yw[j].z), bfhi(yw[j].z), bflo(yw[j].w), bfhi(yw[j].w)}; }
#pragma unroll
    for (int j = 0; j < 16; ++j) s += (y[j].x * y[j].x + y[j].y * y[j].y) + (y[j].z * y[j].z + y[j].w * y[j].w);
    const float r1 = 1.0f / sqrtf(wave_sum(s) * (1.f / DM) + RMS_EPS);
    float s2 = 0.f;
#pragma unroll
    for (int j = 0; j < 16; ++j) { const f32x4 gg = gr[128 * (j >> 1) + (j & 1)]; x[j] = x[j] + (y[j] * r1) * gg; s2 += (x[j].x * x[j].x + x[j].y * x[j].y) + (x[j].z * x[j].z + x[j].w * x[j].w); }
    if constexpr (OUT_F32) { f32x4* xo = (f32x4*)xout + 2 * lane;
#pragma unroll
        for (int j = 0; j < 8; ++j) { xo[128 * j] = x[2 * j]; xo[128 * j + 1] = x[2 * j + 1]; } }
    else { const float var = wave_sum(s2) * (1.f / DM) + RMS_EPS, sd = sqrtf(var), r2 = 1.0f / sd; v4u* o8 = (v4u*)hrow + lane;
#pragma unroll
        for (int j = 0; j < 8; ++j) { v4u w; w.x = cvtpk(x[2 * j].x * r2, x[2 * j].y * r2); w.y = cvtpk(x[2 * j].z * r2, x[2 * j].w * r2); w.z = cvtpk(x[2 * j + 1].x * r2, x[2 * j + 1].y * r2); w.w = cvtpk(x[2 * j + 1].z * r2, x[2 * j + 1].w * r2); o8[64 * j] = w; }
        if (lane == 0) *rinv = sd; }
}
__device__ __forceinline__ void ld8f(const bf16* p, float (&f)[8]) { const v4u w = *(const v4u*)p; f[0] = bflo(w.x); f[1] = bfhi(w.x); f[2] = bflo(w.y); f[3] = bfhi(w.y); f[4] = bflo(w.z); f[5] = bfhi(w.z); f[6] = bflo(w.w); f[7] = bfhi(w.w); }
__device__ __forceinline__ void pool_block(const bf16* __restrict__ U, const bf16* __restrict__ SGp, bf16* __restrict__ PO, int rb, int tid) {
    const int c0 = tid * 8, w = 2 << (c0 >> 10), r0 = rb * 32;
    float s[8] = {0.f, 0.f, 0.f, 0.f, 0.f, 0.f, 0.f, 0.f};
    {
        v4u pre[16];
#pragma unroll
        for (int i = 0; i < 16; ++i) { const int row = r0 - 16 + i; pre[i] = *(const v4u*)(U + (size_t)(row < 0 ? 0 : row) * DM + c0); }
#pragma unroll
        for (int i = 0; i < 16; ++i) { const int row = r0 - 16 + i; const float m = (row >= r0 - w + 1 && row >= 0) ? 1.0f : 0.0f; const v4u q = pre[i];
            s[0] += m * bflo(q.x); s[1] += m * bfhi(q.x); s[2] += m * bflo(q.y); s[3] += m * bfhi(q.y); s[4] += m * bflo(q.z); s[5] += m * bfhi(q.z); s[6] += m * bflo(q.w); s[7] += m * bfhi(q.w); }
    }
    for (int b = 0; b < 4; ++b) {
        const int tb = r0 + 8 * b; v4u cur[8], sub[8], gt[8];
#pragma unroll
        for (int i = 0; i < 8; ++i) { const int t = tb + i, ts = t - w + 1; cur[i] = *(const v4u*)(U + (size_t)t * DM + c0); gt[i] = *(const v4u*)(SGp + (size_t)t * DM + c0);
            sub[i] = *(const v4u*)(U + (size_t)(ts < 0 ? 0 : ts) * DM + c0); }
#pragma unroll
        for (int i = 0; i < 8; ++i) { const int t = tb + i, ts = t - w + 1; const int cnt = (t + 1 < w) ? (t + 1) : w; const float inv = 1.0f / (float)cnt, ms = (ts >= 0) ? 1.0f : 0.0f;
            const float c[8] = {bflo(cur[i].x), bfhi(cur[i].x), bflo(cur[i].y), bfhi(cur[i].y), bflo(cur[i].z), bfhi(cur[i].z), bflo(cur[i].w), bfhi(cur[i].w)};
            const float g[8] = {bflo(gt[i].x), bfhi(gt[i].x), bflo(gt[i].y), bfhi(gt[i].y), bflo(gt[i].z), bfhi(gt[i].z), bflo(gt[i].w), bfhi(gt[i].w)};
            const float u[8] = {bflo(sub[i].x), bfhi(sub[i].x), bflo(sub[i].y), bfhi(sub[i].y), bflo(sub[i].z), bfhi(sub[i].z), bflo(sub[i].w), bfhi(sub[i].w)};
            float o[8];
#pragma unroll
            for (int j = 0; j < 8; ++j) { s[j] += c[j]; o[j] = (s[j] * inv - c[j]) * g[j]; s[j] -= ms * u[j]; }
            v4u wv; wv.x = cvtpk(o[0], o[1]); wv.y = cvtpk(o[2], o[3]); wv.z = cvtpk(o[4], o[5]); wv.w = cvtpk(o[6], o[7]);
            *(v4u*)(PO + (size_t)t * DM + c0) = wv; }
    }
}

namespace sb {
constexpr int NW = 8, QBLK = 32, QB = 128, KVBLK = 64, PITCH = DM;
constexpr int SHM_T = KVBLK * HD * 2, HEAD_B = 2 * SHM_T, BUF_B = 2 * HEAD_B;
static_assert(2 * BUF_B <= RING_BYTES, "attention LDS");
#define KSWZ(row, colB) ((row) * 256 + ((colB) ^ (((row) & 7) << 4)))
#define SBAR() __builtin_amdgcn_sched_barrier(0)
__device__ __forceinline__ int v_rd_base(int lane) { return ((lane & 3) << 3) | (((lane >> 2) & 3) << 6) | (((lane >> 4) & 1) << 5) | (((lane >> 5) & 1) << 8); }
constexpr int v_rd_off(int d0, int ks, int half) { return d0 * 512 + ks * 4096 + half * 2048; }
__device__ __forceinline__ int crow(int r, int hi) { return (r & 3) + 8 * (r >> 2) + 4 * hi; }

__device__ __forceinline__ void qkt(f32x16& p0, f32x16& p1, const LAS char* Kb, int r32, int hi, const bf16x8* qr) {
    p0 = f32x16{}; p1 = f32x16{};
    const LAS char* kb[4];
#pragma unroll
    for (int dd = 0; dd < 4; ++dd) kb[dd] = Kb + KSWZ(r32, (dd * 16 + hi * 8) * 2);
#pragma unroll
    for (int d0 = 0; d0 < 8; ++d0) { const LAS char* a = kb[d0 & 3] + (d0 >> 2) * 128;
        const bf16x8 b0 = *(const LAS bf16x8*)a;
        const bf16x8 b1 = *(const LAS bf16x8*)(a + 32 * 256);
        p0 = __builtin_amdgcn_mfma_f32_32x32x16_bf16(b0, qr[d0], p0, 0, 0, 0);
        p1 = __builtin_amdgcn_mfma_f32_32x32x16_bf16(b1, qr[d0], p1, 0, 0, 0); }
}
__device__ __forceinline__ void pv_tile(f32x16* o, int vb, bf16x8 pa0, bf16x8 pa1, bf16x8 pa2, bf16x8 pa3) {
#define TRRD(dst, off) asm volatile("ds_read_b64_tr_b16 %0, %1 offset:%2" : "=&v"(dst) : "v"(vb), "i"(off) : "memory")
#define TR8(L, H, ks) do { TRRD(L[0], v_rd_off(0, ks, 0)); TRRD(H[0], v_rd_off(0, ks, 1)); TRRD(L[1], v_rd_off(1, ks, 0)); TRRD(H[1], v_rd_off(1, ks, 1)); \
        TRRD(L[2], v_rd_off(2, ks, 0)); TRRD(H[2], v_rd_off(2, ks, 1)); TRRD(L[3], v_rd_off(3, ks, 0)); TRRD(H[3], v_rd_off(3, ks, 1)); } while (0)
#define VF(L, H, d) (bf16x8){L[d][0], L[d][1], L[d][2], L[d][3], H[d][0], H[d][1], H[d][2], H[d][3]}
#define MM4(pa, L, H) do { o[0] = __builtin_amdgcn_mfma_f32_32x32x16_bf16(pa, VF(L, H, 0), o[0], 0, 0, 0); o[1] = __builtin_amdgcn_mfma_f32_32x32x16_bf16(pa, VF(L, H, 1), o[1], 0, 0, 0); \
        o[2] = __builtin_amdgcn_mfma_f32_32x32x16_bf16(pa, VF(L, H, 2), o[2], 0, 0, 0); o[3] = __builtin_amdgcn_mfma_f32_32x32x16_bf16(pa, VF(L, H, 3), o[3], 0, 0, 0); } while (0)
    { s16x4 la[4], ha[4], lb[4], hb[4];
      TR8(la, ha, 0); TR8(lb, hb, 1);
      asm volatile("s_waitcnt lgkmcnt(8)" ::: "memory"); SBAR(); MM4(pa0, la, ha); SBAR();
      { s16x4 lc[4], hc[4]; TR8(lc, hc, 2);
        asm volatile("s_waitcnt lgkmcnt(8)" ::: "memory"); SBAR(); MM4(pa1, lb, hb); SBAR();
        { s16x4 ld[4], hd[4]; TR8(ld, hd, 3);
          asm volatile("s_waitcnt lgkmcnt(8)" ::: "memory"); SBAR(); MM4(pa2, lc, hc); SBAR();
          asm volatile("s_waitcnt lgkmcnt(0)" ::: "memory"); SBAR(); MM4(pa3, ld, hd); SBAR(); } } }
#undef MM4
#undef VF
#undef TR8
#undef TRRD
}
__device__ __forceinline__ void sb_weights(f32x16& p0, f32x16& p1, float& C, int hi, bf16x8& pa0, bf16x8& pa1, bf16x8& pa2, bf16x8& pa3) {
    float G[8];
#pragma unroll
    for (int Q = 0; Q < 8; ++Q) {
        f32x16& p = (Q < 4) ? p0 : p1; const int rb = (Q & 3) * 4;
        const float o0 = __builtin_amdgcn_rcpf(1.0f + __builtin_amdgcn_exp2f(p[rb + 0])), o1 = __builtin_amdgcn_rcpf(1.0f + __builtin_amdgcn_exp2f(p[rb + 1]));
        const float o2 = __builtin_amdgcn_rcpf(1.0f + __builtin_amdgcn_exp2f(p[rb + 2])), o3 = __builtin_amdgcn_rcpf(1.0f + __builtin_amdgcn_exp2f(p[rb + 3]));
        const float E1 = o3 * o2, E0 = E1 * o1; G[Q] = E0 * o0;
        p[rb + 3] = 1.0f - o3; p[rb + 2] = o3 - E1; p[rb + 1] = E1 - E0; p[rb + 0] = E0 - G[Q];
    }
    float R = C;
#pragma unroll
    for (int Q = 7; Q >= 0; --Q) {
        f32x16& p = (Q < 4) ? p0 : p1; const int rb = (Q & 3) * 4;
        const auto rr = __builtin_amdgcn_permlane32_swap(__float_as_uint(G[Q]), __float_as_uint(G[Q]), false, false);
        const float g0 = __uint_as_float(rr[0]), g1 = __uint_as_float(rr[1]);
        const float X = R * g1;
        const float Sq = hi ? R : X;
        R = X * g0;
        p[rb + 0] *= Sq; p[rb + 1] *= Sq; p[rb + 2] *= Sq; p[rb + 3] *= Sq;
    }
    C = R;
#define PK4(P, B_, OUT) do { const unsigned a0 = cvtpk(P[B_ + 0], P[B_ + 1]), a1 = cvtpk(P[B_ + 2], P[B_ + 3]); \
        const unsigned b0 = cvtpk(P[B_ + 4], P[B_ + 5]), b1 = cvtpk(P[B_ + 6], P[B_ + 7]); \
        const auto r0 = __builtin_amdgcn_permlane32_swap(a0, b0, false, false); const auto r1 = __builtin_amdgcn_permlane32_swap(a1, b1, false, false); \
        v4u w = {r0[0], r1[0], r0[1], r1[1]}; OUT = __builtin_bit_cast(bf16x8, w); } while (0)
    PK4(p0, 0, pa0); PK4(p0, 8, pa1); PK4(p1, 0, pa2); PK4(p1, 8, pa3);
#undef PK4
}

__device__ __forceinline__ void attn_unit(int hp, int qb, const bf16* Q, const bf16* __restrict__ Kt, const bf16* __restrict__ Vt, const bf16* __restrict__ SG, bf16* O, LAS char* lds, volatile LAS unsigned* flags) {
    int tid = threadIdx.x; asm volatile("" : "+v"(tid));
    const int wid = __builtin_amdgcn_readfirstlane(tid >> 6), lane = tid & 63, r32 = lane & 31, hi = lane >> 5;
    const int sub = wid & 3, hh = wid >> 2, h = 2 * hp + hh;
    const int P0 = qb * QB, qlo = P0 + sub * QBLK;
    const bf16* Qh = Q + h * HD;
    bf16x8 qr[8];
#pragma unroll
    for (int d0 = 0; d0 < 8; ++d0) qr[d0] = *(const bf16x8*)(Qh + (size_t)(qlo + r32) * PITCH + d0 * 16 + hi * 8);
    const int tileid = wid >> 1, shalf = wid & 1, sh = tileid >> 1, isV = tileid & 1;
    const bf16* Sb = (isV ? Vt : Kt) + (2 * hp + sh) * HD;
    const int rowl = lane >> 4;
    const int offE = isV ? (8 * ((lane >> 4) & 1) + ((lane >> 2) & 3)) * PITCH + 32 * (lane >> 5) + 8 * (lane & 3) : rowl * PITCH + (((lane & 15) ^ rowl) << 3);
    const int offO = isV ? offE + 64 : rowl * PITCH + (((lane & 15) ^ (4 + rowl)) << 3);
    LAS char* sdst = lds + sh * HEAD_B + isV * SHM_T + shalf * 8192;
#define STAGE(j, buf) do { const bf16* sp_ = Sb + (size_t)(j) * KVBLK * PITCH; _Pragma("unroll") for (int ii = 0; ii < 8; ++ii) { \
        const int rterm = isV ? (32 * shalf + 16 * (ii >> 2) + 4 * ((ii >> 1) & 1)) * PITCH : (32 * shalf + 4 * ii) * PITCH; \
        __builtin_amdgcn_global_load_lds((const unsigned*)(sp_ + rterm + ((ii & 1) ? offO : offE)), (LAS unsigned*)(sdst + (buf) * BUF_B + ii * 1024), 16, 0, 0); } } while (0)
    const int vb0 = (int)(unsigned)(uintptr_t)(lds + hh * HEAD_B + SHM_T) + v_rd_base(lane);
    const LAS char* K_lds = lds + hh * HEAD_B;
    const int j_hi = 2 * qb + 2;
    STAGE(j_hi - 1, 0);
    VM_WAIT();
    __syncthreads();
    float C = 1.0f; bool done = false; f32x16 o[4] = {};
    for (int t = 0;; ++t) {
        const int j = j_hi - 1 - t, buf = t & 1;
        if (j > 0) STAGE(j - 1, buf ^ 1);
        const bool act = !done && (j * KVBLK <= qlo + QBLK - 1);
        if (act) {
            f32x16 p0, p1; bf16x8 pa0, pa1, pa2, pa3;
            qkt(p0, p1, K_lds + buf * BUF_B, r32, hi, qr);
            if (j * KVBLK + KVBLK - 1 >= qlo) {
                const int dq = qlo + r32 - 4 * hi - j * KVBLK; const float NEG = -__builtin_inff();
#pragma unroll
                for (int r = 0; r < 16; ++r) { const int c = (r & 3) + 8 * (r >> 2); if (dq - c <= 0) p0[r] = NEG; if (dq - c - 32 <= 0) p1[r] = NEG; }
            }
            sb_weights(p0, p1, C, hi, pa0, pa1, pa2, pa3);
            pv_tile(o, vb0 + buf * BUF_B, pa0, pa1, pa2, pa3);
#if SB_EARLY_EXIT
            if (__all(C == 0.0f)) done = true;
#endif
        }
#if SB_EARLY_EXIT
        if (lane == 0) flags[buf * NW + wid] = done ? 1u : 0u;
#endif
        VM_WAIT();
        __syncthreads();
        if (j == 0) break;
#if SB_EARLY_EXIT
        { unsigned nd = 0;
#pragma unroll
          for (int w = 0; w < NW; ++w) nd += flags[buf * NW + w];
          if (nd == (unsigned)NW) break; }
#endif
    }
#undef STAGE
    LAS bf16* stg = (LAS bf16*)(lds + wid * 8192);
#pragma unroll
    for (int r = 0; r < 16; ++r) { const int orow = crow(r, hi);
#pragma unroll
        for (int d0 = 0; d0 < 4; ++d0) { const unsigned w = cvtpk(o[d0][r], 0.f); stg[orow * HD + d0 * 32 + r32] = (bf16)(w & 0xffffu); } }
    LDS_WAIT(); asm volatile("" ::: "memory");
#pragma unroll
    for (int i = 0; i < 8; ++i) { const int row = i * 4 + (lane >> 4), ch = lane & 15;
        const v4u v = *(const LAS v4u*)(stg + row * HD + ch * 8);
        const size_t off = (size_t)(qlo + row) * PITCH + h * HD + ch * 8;
        const v4u g = *(const v4u*)(SG + off);
        v4u w; w.x = cvtpk(bflo(v.x) * bflo(g.x), bfhi(v.x) * bfhi(g.x)); w.y = cvtpk(bflo(v.y) * bflo(g.y), bfhi(v.y) * bfhi(g.y));
        w.z = cvtpk(bflo(v.z) * bflo(g.z), bfhi(v.z) * bfhi(g.z)); w.w = cvtpk(bflo(v.w) * bflo(g.w), bfhi(v.w) * bfhi(g.w));
        *(v4u*)(O + off) = w; }
    __syncthreads();
}
#undef KSWZ
#undef SBAR
}

constexpr int DEF_I_IN = (DM / 64) * (2 * DM / 64), DEF_I_OUT = (DM / 64) * (DM / 64), DEF_N = 3 * DEF_I_IN + 2 * DEF_I_OUT;
struct Args; typedef const __attribute__((address_space(4))) Args* KArgs;
__device__ __forceinline__ void deferred_item(int r, const float* w_kv, const float* kv_norm, const float* b_w_in, const float* b_pre, const float* b_w_out, unsigned char* ws, LAS unsigned char* scr, int lane) {
    const float* W; int ld; bf16* WT; int row_off = 0; const float* gk;
    if (r < DEF_I_IN) { W = w_kv; ld = 2 * DM; WT = (bf16*)(ws + WS_WKVQ); gk = kv_norm; }
    else if (r < 2 * DEF_I_IN) { r -= DEF_I_IN; W = b_w_in; ld = 2 * DM; WT = (bf16*)(ws + WS_WKVQ); row_off = 2 * DM; gk = b_pre; }
    else if (r < 3 * DEF_I_IN) { r -= 2 * DEF_I_IN; W = b_w_in + (size_t)DM * 2 * DM; ld = 2 * DM; WT = (bf16*)(ws + WS_WBIN1); gk = b_pre + DM; }
    else { r -= 3 * DEF_I_IN; const int l = r / DEF_I_OUT; r -= l * DEF_I_OUT; W = b_w_out + (size_t)l * DM * DM; ld = DM; WT = (bf16*)(ws + WS_WBOUT) + (size_t)l * DM * DM; gk = nullptr; }
    transpose_item(W, ld, ld, WT, DM, row_off, gk, nullptr, scr, r, lane);
}

struct Args { const float* in[13]; float* out; unsigned char* ws; };
typedef const __attribute__((address_space(4))) Args* KArgs;
#define PHASE_ARGS() KArgs ka = ka0; asm volatile("" : "+s"(ka)); unsigned char* const ws = ka->ws; (void)ws; \
    int tid = threadIdx.x; asm volatile("" : "+v"(tid)); const int lane = tid & 63, wave = __builtin_amdgcn_readfirstlane(tid >> 6); (void)lane; (void)wave; \
    const int G = gridDim.x, bx = blockIdx.x, gw = bx * NWAVES + wave, NGW = G * NWAVES; (void)gw; (void)NGW
__global__ void __launch_bounds__(NWAVES * 64, 2) yoco_fwd(Args args_unused) {
    extern __shared__ __attribute__((aligned(16))) unsigned char lds_raw[];
    LAS unsigned char* lds = (LAS unsigned char*)lds_raw;
    const KArgs ka0 = (KArgs)__builtin_amdgcn_kernarg_segment_ptr();
    XcdBarrier bar;
    {
        volatile LAS unsigned* MISC = (volatile LAS unsigned*)(lds + MISC_OFF);
        for (int u = threadIdx.x; u < (LDS_BYTES - LDSCTL_OFF) / 4; u += NWAVES * 64) ((LAS unsigned*)(lds + LDSCTL_OFF))[u] = 0u;
        __syncthreads();
        bar = xcd_barrier_post((unsigned*)(ka0->ws + WS_CTL) + CW_BAR, MISC + 8);
    }
#define GRID_BAR() xcd_barrier(bar)

#define STEAL(site, limit) do { PHASE_ARGS(); gu32* ctl_ = (gu32*)(ws + WS_CTL); volatile LAS unsigned* sh_ = (volatile LAS unsigned*)(lds + LDSCTL_OFF + 128); \
        const float* w_kv_ = ka->in[8]; const float* kvn_ = ka->in[7]; const float* bwi_ = ka->in[10]; const float* bpre_ = ka->in[9]; const float* bwo_ = ka->in[11]; \
        asm volatile("s_waitcnt vmcnt(0)" ::: "memory"); __syncthreads(); \
        if ((site) >= 0 && tid == 0) __hip_atomic_fetch_add(ctl_ + CW_DONE + 64 * ((site) < 0 ? 0 : (site)), 1u, RLX_AGENT); \
        for (int par_ = 0;; par_ ^= 1) { \
            if (tid == 0) { unsigned stop_ = 0u, base_ = 0u; \
                if ((site) >= 0 && __hip_atomic_load(ctl_ + CW_DONE + 64 * ((site) < 0 ? 0 : (site)), RLX_AGENT) >= (unsigned)G) stop_ = 1u; \
                else if ((site) < 0 && __hip_atomic_load(ctl_ + CW_STEALQ, RLX_AGENT) >= (unsigned)(limit)) stop_ = 1u;     \
                else { base_ = __hip_atomic_fetch_add(ctl_ + CW_STEALQ, 16u, RLX_AGENT); if (base_ >= (unsigned)DEF_N) stop_ = 1u; } \
                sh_[2 * par_] = base_; sh_[2 * par_ + 1] = stop_; } \
            __syncthreads(); \
            const unsigned base_ = sh_[2 * par_], stop_ = sh_[2 * par_ + 1]; \
            if (stop_) break; \
            for (int rep_ = 0; rep_ < 2; ++rep_) { const int item_ = (int)base_ + 8 * rep_ + wave; \
                if (item_ < DEF_N) deferred_item(item_, w_kv_, kvn_, bwi_, bpre_, bwo_, ws, lds + RING_OFF + wave * 8192, lane); } } } while (0)

    {
        PHASE_ARGS();
        const float* a_pre = ka->in[1]; const float* a_w_in = ka->in[2]; const float* a_w_group = ka->in[3]; const float* a_scale = ka->in[4];
        bf16* WAG = (bf16*)(ws + WS_WAG);
        LAS unsigned char* scr = lds + RING_OFF + wave * 8192;
        constexpr int I_G = (1024 / 64) * (1024 / 64);
        constexpr int I_ROW = 2 * DM;
        bf16* WINU = (bf16*)(ws + WS_PO);
        for (int it = gw; it < I_ROW + 8 * I_G; it += NGW) {
            int r = it;
            if (r < I_ROW) { const int l = r >> 12, k = r & 4095; convert_row(a_w_in + (size_t)l * DM * 2 * DM + (size_t)k * 2 * DM, WINU + (size_t)k * 2 * DM + l * DM, a_pre[l * DM + k], lane); continue; } r -= I_ROW;
            { const int lg = r / I_G; r -= lg * I_G; const int l = lg >> 2, gq = lg & 3;
              transpose_item(a_w_group + (size_t)lg * 1024 * 1024, 1024, 1024, WAG + (size_t)l * DM * 1024, 1024, gq * 1024, nullptr, a_scale + l * DM + gq * 1024, scr, r, lane); }
        }
    }
    GRID_BAR();
#define P0_REST() do { PHASE_ARGS(); \
        const float* a_pre = ka->in[1]; const float* a_w_in = ka->in[2]; const float* a_w_out = ka->in[5]; \
        bf16* WAIN = (bf16*)(ws + WS_WAIN); bf16* WAOUT = (bf16*)(ws + WS_WAOUT); \
        LAS unsigned char* scr = lds + RING_OFF + wave * 8192; \
        constexpr int I_OUT = (DM / 64) * (DM / 64);           \
        for (int it = gw; it < 4 * I_OUT; it += NGW) { \
            int r = it; \
            if (r < 2 * I_OUT) { const int l = r / I_OUT; r -= l * I_OUT;     \
                transpose_item(a_w_in + (size_t)l * DM * 2 * DM + DM, 2 * DM, DM, WAIN + (size_t)l * 2 * DM * DM, DM, DM, a_pre + l * DM, nullptr, scr, r, lane); continue; } r -= 2 * I_OUT; \
            { const int l = r / I_OUT; r -= l * I_OUT; transpose_item(a_w_out + (size_t)l * DM * DM, DM, DM, WAOUT + (size_t)l * DM * DM, DM, 0, nullptr, nullptr, scr, r, lane); } \
        } \
        const float* x_in = ka->in[0]; bf16* HB = (bf16*)(ws + WS_HB); \
        float* RS = (float*)(ws + WS_RS); for (int m = gw; m < S; m += NGW) rms_row_to_bf16(x_in + (size_t)m * DM, HB + (size_t)m * DM, RS + m, lane); \
        asm volatile("s_waitcnt vmcnt(0) lgkmcnt(0)" ::: "memory"); __syncthreads(); } while (0)
    const bool conv_first = ((blockIdx.x >> 3) & 1) != 0;
    if (conv_first) P0_REST();
    {
        PHASE_ARGS();
        pg8::Gemm g{(const bf16*)(ws + WS_WAG), (const bf16*)(ws + WS_PO), 2 * DM, DM, 1024, 1024, 2 * DM, 1 << 20, 4}; pg8::StaticOrder So; So.init(2 * DM, DM, G, bx);
        pg8::EpiSeg<false> E{(bf16*)(ws + WS_WAIN), -1, -1, 1.f, nullptr, DM, DM};
        pg8::gemm_phase<pg8::EpiSeg<false>, pg8::StaticOrder, PG8_ALIGN, PG8_SP2>(lds + RING_OFF, g, So, E);
    }
    if (!conv_first) P0_REST();
#undef P0_REST
    STEAL(0, DEF_N);
    GRID_BAR();

    for (int l = 0; l < 2; ++l) {
        {
            PHASE_ARGS();
            pg8::Gemm g{(const bf16*)(ws + WS_HB), (const bf16*)(ws + WS_WAIN) + (size_t)l * 2 * DM * DM, S, 2 * DM, DM, DM, DM, 1 << 20, 1 << 20}; pg8::StaticOrder So; So.init(S, 2 * DM, G, bx);
            pg8::EpiSeg<false> E{(bf16*)(ws + WS_U), -1, 1, 1.f, nullptr, 1 << 30, 0};
            pg8::gemm_phase<pg8::EpiSeg<false>, pg8::StaticOrder, PG8_ALIGN, PG8_SP2>(lds + RING_OFF, g, So, E);
        }
        STEAL(1 + 2 * l, DEF_N);
        GRID_BAR();
        {
            PHASE_ARGS();
            for (int rb = bx; rb < S / 32; rb += G) pool_block((const bf16*)(ws + WS_U), (const bf16*)(ws + WS_SG), (bf16*)(ws + WS_PO), rb, tid);
        }
        GRID_BAR();
        {
            PHASE_ARGS();
            pg8::Gemm g{(const bf16*)(ws + WS_PO), (const bf16*)(ws + WS_WAOUT) + (size_t)l * DM * DM, S, DM, DM, DM, DM, 1 << 20, 1 << 20}; pg8::StaticOrder So; So.init(S, DM, G, bx);
            pg8::EpiSeg<false> E{(bf16*)(ws + WS_Y), -1, -1, 1.f, nullptr, 1 << 30, 0};
            pg8::gemm_phase<pg8::EpiSeg<false>, pg8::StaticOrder, PG8_ALIGN, PG8_SP2>(lds + RING_OFF, g, So, E);
        }
        STEAL(2 + 2 * l, DEF_N);
        GRID_BAR();
        {
            PHASE_ARGS();
            const float* gp = ka->in[6] + l * DM; float* RS = (float*)(ws + WS_RS);
            const bf16* YB = (const bf16*)(ws + WS_Y); bf16* HB = (bf16*)(ws + WS_HB);
            for (int m = gw; m < S; m += NGW) norm_res_row<false, false>(nullptr, HB + (size_t)m * DM, RS + m, YB + (size_t)m * DM, gp, nullptr, lane);
        }
        if (l == 1) STEAL(-1, 2 * DEF_I_IN);
        GRID_BAR();
    }

    for (int jl = 0; jl < 2; ++jl) {
        {
            PHASE_ARGS();
            const int N = (jl == 0) ? 4 * DM : 2 * DM;
            pg8::Gemm g{(const bf16*)(ws + WS_HB), (const bf16*)(ws + ((jl == 0) ? WS_WKVQ : WS_WBIN1)), S, N, DM, DM, DM, 1 << 20, 1 << 20}; pg8::StaticOrder So; So.init(S, N, G, bx);
            pg8::EpiSeg<false> E{(bf16*)(ws + ((jl == 0) ? WS_K : WS_U)), (jl == 0) ? 2 : 0, (jl == 0) ? 3 : 1, QSCALE, nullptr, 1 << 30, 0};
            pg8::gemm_phase<pg8::EpiSeg<false>, pg8::StaticOrder, PG8_ALIGN, PG8_SP2>(lds + RING_OFF, g, So, E);
        }
        STEAL(5 + jl, DEF_N);
        GRID_BAR();
        {
            PHASE_ARGS();
            bf16* UB = (bf16*)(ws + WS_U); const bf16* KB = (const bf16*)(ws + WS_K); const bf16* VB = (const bf16*)(ws + WS_V); const bf16* SGB = (const bf16*)(ws + WS_SG);
            const unsigned mode_dn = __builtin_amdgcn_s_getreg((2 - 1) << 11 | 4 << 6 | 1);
            __builtin_amdgcn_s_setreg((2 - 1) << 11 | 4 << 6 | 1, 0u);
            for (int u = bx; u < 1024; u += G) { const int xcd = u & 7, k = u >> 3, hp = xcd + 8 * (k >> 6), qb = 63 - (k & 63);
                sb::attn_unit(hp, qb, UB, KB, VB, SGB, UB, (LAS char*)(lds + RING_OFF), (volatile LAS unsigned*)(lds + LDSCTL_OFF)); }
            __builtin_amdgcn_s_setreg((2 - 1) << 11 | 4 << 6 | 1, mode_dn);
        }
        STEAL(-1, 3 * DEF_I_IN + (jl + 1) * DEF_I_OUT);
        GRID_BAR();
        {
            PHASE_ARGS();
            pg8::Gemm g{(const bf16*)(ws + WS_U), (const bf16*)(ws + WS_WBOUT) + (size_t)jl * DM * DM, S, DM, DM, DM, DM, 1 << 20, 1 << 20}; pg8::StaticOrder So; So.init(S, DM, G, bx);
            pg8::EpiSeg<false> E{(bf16*)(ws + WS_Y), -1, -1, 1.f, nullptr, 1 << 30, 0};
            pg8::gemm_phase<pg8::EpiSeg<false>, pg8::StaticOrder, PG8_ALIGN, PG8_SP2>(lds + RING_OFF, g, So, E);
        }
        GRID_BAR();
        {
            PHASE_ARGS();
            float* xout = ka->out; const float* gp = ka->in[12] + jl * DM; const bf16* YB = (const bf16*)(ws + WS_Y); bf16* HB = (bf16*)(ws + WS_HB); float* RS = (float*)(ws + WS_RS);
            if (jl == 0) { for (int m = gw; m < S; m += NGW) norm_res_row<false, false>(nullptr, HB + (size_t)m * DM, RS + m, YB + (size_t)m * DM, gp, nullptr, lane); }
            else { for (int m = gw; m < S; m += NGW) norm_res_row<false, true>(nullptr, HB + (size_t)m * DM, RS + m, YB + (size_t)m * DM, gp, xout + (size_t)m * DM, lane); }
        }
        if (jl == 0) GRID_BAR();
    }
#undef GRID_BAR
}

extern "C" void kernel_launch(void* const* d_in, const int* in_sizes, int n_in, void* d_out, int out_size, void* d_ws, size_t ws_size, hipStream_t stream) {
    static int grid = 0;
    if (grid == 0) {
        if (n_in != 13 || in_sizes[0] != S * DM || out_size != S * DM || ws_size < WS_END) {
            fprintf(stderr, "kernel_launch: unexpected shapes (n_in %d, in0 %d, out %d, ws %zu); nothing launched\n", n_in, n_in > 0 ? in_sizes[0] : -1, out_size, ws_size); grid = -1; return; }
        int dev = 0, cus = 0, per_cu = 0;
        if (hipGetDevice(&dev) != hipSuccess || hipDeviceGetAttribute(&cus, hipDeviceAttributeMultiprocessorCount, dev) != hipSuccess) { fprintf(stderr, "kernel_launch: device query failed\n"); grid = -1; return; }
        if (hipFuncSetAttribute((const void*)yoco_fwd, hipFuncAttributeMaxDynamicSharedMemorySize, LDS_BYTES) != hipSuccess) { fprintf(stderr, "kernel_launch: hipFuncSetAttribute failed\n"); grid = -1; return; }
        if (hipOccupancyMaxActiveBlocksPerMultiprocessor(&per_cu, (const void*)yoco_fwd, NWAVES * 64, LDS_BYTES) != hipSuccess || per_cu < 1)
            fprintf(stderr, "kernel_launch: note: occupancy query reports %d workgroups per CU\n", per_cu);
        (void)hipGetLastError();
        grid = cus;
    }
    if (grid < 0) return;
    if (hipMemsetAsync((char*)d_ws + WS_CTL, 0, CTL_ZERO_BYTES, stream) != hipSuccess) { fprintf(stderr, "kernel_launch: memset failed\n"); return; }
    Args a{};
    for (int i = 0; i < 13; ++i) a.in[i] = (const float*)d_in[i];
    a.out = (float*)d_out; a.ws = (unsigned char*)d_ws;
    hipLaunchKernelGGL(yoco_fwd, dim3(grid), dim3(NWAVES * 64), LDS_BYTES, stream, a);
    const hipError_t le = hipPeekAtLastError();
    if (le != hipSuccess) fprintf(stderr, "kernel_launch: launch failed: %s\n", hipGetErrorName(le));
}
```

```cpp
#include <hip/hip_runtime.h>
#include <cstdio>
#include <cstdint>

#ifndef SB_EARLY_EXIT
#define SB_EARLY_EXIT 1
#endif

namespace pg8 {
#define PG8_LAS __attribute__((address_space(3)))
typedef unsigned short bf16_t;
typedef short bf16x8 __attribute__((ext_vector_type(8)));
typedef float f32x4 __attribute__((ext_vector_type(4)));
typedef unsigned u32x4 __attribute__((ext_vector_type(4)));
constexpr int BM = 256, BK = 64, HALF = 128, HTB = HALF * BK * 2  , STAGE_BYTES = 8 * HTB, NXCD = 8, WGM = 8;

__host__ __device__ __forceinline__ int lds_byte(int r, int c) { const int st = (r >> 4) * 2 + (c >> 5), rr = r & 15, cc = c & 31, ob = rr * 64 + cc * 2; return st * 1024 + (ob ^ (((ob >> 9) & 1) << 5)); }
__host__ __device__ __forceinline__ void stage_rc(int b, int& R, int& C) { const int st = b / 1024, sb = b % 1024, swz = sb ^ (((sb >> 9) & 1) << 5); R = (st >> 1) * 16 + swz / 64; C = (st & 1) * 32 + (swz % 64) / 2; }
__host__ __device__ __forceinline__ int perm32(int rho) { const int n = rho >> 4, i = rho & 15; return 8 * (i >> 2) + 4 * n + (i & 3); }

struct Unit { int pm, pn; };
struct Gemm { const bf16_t* A; const bf16_t* Bt; int M, N, K, lda, ldb, agdiv, bgdiv; };

struct StaticOrder {
    int nM, nN, nwg, G, c;
    __host__ __device__ void init(int M, int N, int G_, int c_) { nM = M / BM; nN = N / BM; nwg = nM * nN; G = G_; c = c_; }
    __host__ __device__ bool next(int i, Unit& u) const {
        const long L = (long)i * G + c; if (L >= nwg) return false;
        int wgid = (int)L; { const int q = nwg / NXCD, r = nwg % NXCD, xcd = wgid % NXCD, off = wgid / NXCD; wgid = (xcd < r ? xcd * (q + 1) : r * (q + 1) + (xcd - r) * q) + off; }
        const int nig = WGM * nN, gid = wgid / nig, fm = gid * WGM, gsz = (nM - fm) < WGM ? (nM - fm) : WGM;
        u.pm = fm + ((wgid % nig) % gsz); u.pn = (wgid % nig) / gsz; return true;
    }
    __device__ __forceinline__ void a_ready(const Unit&) const {}
    __device__ __forceinline__ void done(const Unit&) const {}
};

__device__ __forceinline__ unsigned cvt_pk_bf16(float lo, float hi) { unsigned r; asm volatile("v_cvt_pk_bf16_f32 %0, %1, %2" : "=v"(r) : "v"(lo), "v"(hi)); return r; }
__device__ __forceinline__ float bf_lo(unsigned w) { return __uint_as_float(w << 16); }
__device__ __forceinline__ float bf_hi(unsigned w) { return __uint_as_float(w & 0xffff0000u); }
__device__ __forceinline__ float silu_f(float v) { const float e = __builtin_amdgcn_exp2f(v * -1.4426950408889634f); return v * __builtin_amdgcn_rcpf(1.0f + e); }

struct EpiF32 {
    static constexpr bool PERM = false, AFTER_DRAIN = false;
    float* C; int ldc;
    __device__ __forceinline__ void operator()(const f32x4 (&acc)[2][2][4][2], const Unit& u, int wr, int wc, int fr, int fq) const {
        const int row0 = u.pm * BM + wr * 64 + fr, col0 = u.pn * BM + wc * 32 + 4 * fq;
#pragma unroll
        for (int ai = 0; ai < 2; ++ai)
#pragma unroll
            for (int m = 0; m < 4; ++m) { float* rowp = C + (size_t)(row0 + ai * HALF + m * 16) * ldc + col0;
#pragma unroll
                for (int bj = 0; bj < 2; ++bj)
#pragma unroll
                    for (int n = 0; n < 2; ++n) *(f32x4*)(rowp + bj * HALF + n * 16) = acc[ai][bj][m][n]; }
    }
};
template <bool HAS_MUL> struct EpiSeg {
    static constexpr bool PERM = true, AFTER_DRAIN = false;
    static constexpr size_t SEG_ELEMS = (size_t)8192 * 4096;
    bf16_t* d; int qseg, gseg; float qscale; const bf16_t* mul; int rsplit, rjump;
    __device__ __forceinline__ void operator()(const f32x4 (&acc)[2][2][4][2], const Unit& u, int wr, int wc, int fr, int fq) const {
        const int row0 = u.pm * BM + ((u.pm * BM >= rsplit) ? rjump : 0) + wr * 64 + fr; int colt = u.pn * BM; const int seg = colt >> 12; colt &= 4095;
        bf16_t* base = d + (size_t)seg * SEG_ELEMS; const float sc = (seg == qseg) ? qscale : 1.0f;
        const bool silu = (seg == gseg);
        const int col0 = colt + wc * 32 + 8 * fq;
#pragma unroll
        for (int ai = 0; ai < 2; ++ai)
#pragma unroll
            for (int m = 0; m < 4; ++m) { const size_t off = (size_t)(row0 + ai * HALF + m * 16) * 4096 + col0;
#pragma unroll
                for (int bj = 0; bj < 2; ++bj) { f32x4 v0 = acc[ai][bj][m][0] * sc, v1 = acc[ai][bj][m][1] * sc;
                    if (silu) {
#pragma unroll
                        for (int j = 0; j < 4; ++j) { v0[j] = silu_f(v0[j]); v1[j] = silu_f(v1[j]); } }
                    if (HAS_MUL) { const u32x4 g = *(const u32x4*)(mul + off + bj * HALF);
                        v0[0] *= bf_lo(g.x); v0[1] *= bf_hi(g.x); v0[2] *= bf_lo(g.y); v0[3] *= bf_hi(g.y); v1[0] *= bf_lo(g.z); v1[1] *= bf_hi(g.z); v1[2] *= bf_lo(g.w); v1[3] *= bf_hi(g.w); }
                    u32x4 w; w.x = cvt_pk_bf16(v0[0], v0[1]); w.y = cvt_pk_bf16(v0[2], v0[3]); w.z = cvt_pk_bf16(v1[0], v1[1]); w.w = cvt_pk_bf16(v1[2], v1[3]);
                    *(u32x4*)(base + off + bj * HALF) = w; } }
    }
};

template <class Epi, class Sched, bool ALIGN_EPI = false, bool SP2 = false>
__device__ __forceinline__ void gemm_phase(PG8_LAS unsigned char* lds, const Gemm g, const Sched& S, const Epi& E) {
    int tid = threadIdx.x; asm volatile("" : "+v"(tid));
    const int wid = __builtin_amdgcn_readfirstlane(tid >> 6), lane = tid & 63, wr = wid >> 2, wc = wid & 3, fr = lane & 15, fq = lane >> 4;
    const int K = g.K, nt = K / BK;
    unsigned voffA[2], voffB[2];
#pragma unroll
    for (int i = 0; i < 2; ++i) { int R, C; stage_rc(tid * 16 + i * 8192, R, C); const int Rb = Epi::PERM ? ((R & ~31) + perm32(R & 31)) : R;
        voffA[i] = (unsigned)(R * g.lda + C) * 2u; voffB[i] = (unsigned)(Rb * g.ldb + C) * 2u; }
    const size_t kstep = (size_t)(BK * 2);
    const size_t hstepA = (size_t)HALF * g.lda * 2, hstepB = (size_t)HALF * g.ldb * 2;
    const size_t tstepA = 2 * hstepA, tstepB = 2 * hstepB;
    const unsigned ldsw = (unsigned)wid * 1024u;
    const int aoff = lds_byte(wr * 64 + fr, fq * 8), boff = lds_byte(wc * 32 + fr, fq * 8);
#define PG8_SA(b, h) (((b) * 2 + (h)) * HTB)
#define PG8_SB(b, h) ((4 + (b) * 2 + (h)) * HTB)
#define PG8_STAGE(bufoff, gbase, voff) do { _Pragma("unroll") for (int _i = 0; _i < 2; ++_i) \
        __builtin_amdgcn_global_load_lds((const unsigned*)((const char*)(gbase) + (voff)[_i]), (PG8_LAS unsigned*)(lds + (bufoff) + ldsw + _i * 8192), 16, 0, 0); } while (0)
#define PG8_LDA(dst, b, h) do { _Pragma("unroll") for (int m = 0; m < 4; ++m) _Pragma("unroll") for (int k = 0; k < 2; ++k) dst[m][k] = *(const PG8_LAS bf16x8*)(lds + PG8_SA(b, h) + aoff + m * 2048 + k * 1024); } while (0)
#define PG8_LDB(dst, b, h) do { _Pragma("unroll") for (int n = 0; n < 2; ++n) _Pragma("unroll") for (int k = 0; k < 2; ++k) dst[n][k] = *(const PG8_LAS bf16x8*)(lds + PG8_SB(b, h) + boff + n * 2048 + k * 1024); } while (0)
#define PG8_MMA(ai, bj, At, Bt) do { __builtin_amdgcn_s_setprio(1); _Pragma("unroll") for (int m = 0; m < 4; ++m) _Pragma("unroll") for (int n = 0; n < 2; ++n) _Pragma("unroll") for (int k = 0; k < 2; ++k) \
        acc[ai][bj][m][n] = __builtin_amdgcn_mfma_f32_16x16x32_bf16(Bt[n][k], At[m][k], acc[ai][bj][m][n], 0, 0, 0); __builtin_amdgcn_s_setprio(0); } while (0)
#define PG8_WAIT_V(n) asm volatile("s_waitcnt vmcnt(" #n ")" ::: "memory")
#define PG8_WAIT_L(n) asm volatile("s_waitcnt lgkmcnt(" #n ")" ::: "memory")
#define PG8_BAR __builtin_amdgcn_s_barrier()
#define PG8_SCHED __builtin_amdgcn_sched_barrier(0)
#define PG8_ABASE(u) ((const char*)g.A + (size_t)(u).pm * tstepA + (size_t)((u).pn / g.agdiv) * (size_t)K * 2)
#define PG8_BBASE(u) ((const char*)g.Bt + (size_t)(u).pn * tstepB + (size_t)((u).pm / g.bgdiv) * (size_t)K * 2)
    Unit cur, nxt; int ui = 0;
    if (!S.next(0, cur)) return;
    f32x4 acc[2][2][4][2];
#pragma unroll
    for (int a = 0; a < 2; ++a)
#pragma unroll
        for (int b = 0; b < 2; ++b)
#pragma unroll
            for (int m = 0; m < 4; ++m)
#pragma unroll
                for (int n = 0; n < 2; ++n) acc[a][b][m][n] = (f32x4){0.f, 0.f, 0.f, 0.f};
    bf16x8 At[4][2], B0[2][2], B1[2][2];
    const char* cA = PG8_ABASE(cur); const char* cB = PG8_BBASE(cur);
    S.a_ready(cur);
    if constexpr (SP2) {
        PG8_STAGE(PG8_SB(0, 0), cB, voffB); PG8_STAGE(PG8_SB(0, 1), cB + hstepB, voffB); PG8_STAGE(PG8_SA(0, 0), cA, voffA); PG8_STAGE(PG8_SA(0, 1), cA + hstepA, voffA);
        if (wr == 1) PG8_BAR;
        PG8_WAIT_V(2); PG8_BAR;
        PG8_STAGE(PG8_SB(1, 0), cB + kstep, voffB); PG8_STAGE(PG8_SA(1, 0), cA + kstep, voffA); PG8_STAGE(PG8_SB(1, 1), cB + hstepB + kstep, voffB);
        PG8_WAIT_V(6); PG8_BAR;
    } else {
        PG8_STAGE(PG8_SB(0, 0), cB, voffB); PG8_STAGE(PG8_SA(0, 0), cA, voffA); PG8_STAGE(PG8_SB(0, 1), cB + hstepB, voffB); PG8_STAGE(PG8_SA(0, 1), cA + hstepA, voffA);
        if (wr == 1) PG8_BAR;
        PG8_WAIT_V(4); PG8_BAR;
        PG8_STAGE(PG8_SB(1, 0), cB + kstep, voffB); PG8_STAGE(PG8_SA(1, 0), cA + kstep, voffA); PG8_STAGE(PG8_SB(1, 1), cB + hstepB + kstep, voffB);
        PG8_WAIT_V(6); PG8_BAR;
    }
    for (;;) {
        const bool has_next = S.next(ui + 1, nxt);
        const char* nA = has_next ? PG8_ABASE(nxt) : cA; const char* nB = has_next ? PG8_BBASE(nxt) : cB;
        for (int t = 0; t < nt; t += 2) {
            const bool last = (t == nt - 2);
            const char* a1 = cA + (size_t)(t + 1) * kstep;
            const char* a2 = last ? nA : cA + (size_t)(t + 2) * kstep; const char* b2 = last ? nB : cB + (size_t)(t + 2) * kstep;
            const char* a3 = a2 + kstep; const char* b3 = b2 + kstep;
            if (last && has_next) S.a_ready(nxt);
            if constexpr (SP2) {
            PG8_LDB(B0, 0, 0); PG8_LDB(B1, 0, 1); PG8_SCHED; PG8_LDA(At, 0, 0); PG8_STAGE(PG8_SA(1, 1), a1 + hstepA, voffA);
            PG8_WAIT_V(8); PG8_WAIT_L(0); PG8_BAR; PG8_MMA(0, 0, At, B0); PG8_MMA(0, 1, At, B1); PG8_BAR; PG8_SCHED;
            PG8_LDA(At, 0, 1); PG8_STAGE(PG8_SB(0, 0), b2, voffB); PG8_STAGE(PG8_SB(0, 1), b2 + hstepB, voffB); PG8_STAGE(PG8_SA(0, 0), a2, voffA);
            PG8_WAIT_V(8); PG8_WAIT_L(0); PG8_BAR; PG8_MMA(1, 0, At, B0); PG8_MMA(1, 1, At, B1); PG8_BAR; PG8_SCHED;
            PG8_LDB(B0, 1, 0); PG8_LDB(B1, 1, 1); PG8_SCHED; PG8_LDA(At, 1, 0); PG8_STAGE(PG8_SA(0, 1), a2 + hstepA, voffA);
            PG8_WAIT_V(8); PG8_WAIT_L(0); PG8_BAR; PG8_MMA(0, 0, At, B0); PG8_MMA(0, 1, At, B1); PG8_BAR; PG8_SCHED;
            PG8_LDA(At, 1, 1); PG8_STAGE(PG8_SB(1, 0), b3, voffB); PG8_STAGE(PG8_SB(1, 1), b3 + hstepB, voffB); PG8_STAGE(PG8_SA(1, 0), a3, voffA);
            PG8_WAIT_V(8); PG8_WAIT_L(0); PG8_BAR; PG8_MMA(1, 0, At, B0); PG8_MMA(1, 1, At, B1); PG8_BAR; PG8_SCHED;
            } else {
            PG8_LDB(B0, 0, 0); PG8_SCHED; PG8_LDA(At, 0, 0); PG8_STAGE(PG8_SA(1, 1), a1 + hstepA, voffA);
            PG8_WAIT_L(8); PG8_BAR; PG8_WAIT_L(0); PG8_MMA(0, 0, At, B0); PG8_BAR; PG8_SCHED;
            PG8_LDB(B1, 0, 1); PG8_STAGE(PG8_SB(0, 0), b2, voffB);
            PG8_BAR; PG8_WAIT_L(0); PG8_MMA(0, 1, At, B1); PG8_BAR;
            PG8_LDA(At, 0, 1); PG8_STAGE(PG8_SA(0, 0), a2, voffA);
            PG8_BAR; PG8_WAIT_L(0); PG8_MMA(1, 0, At, B0); PG8_BAR; PG8_SCHED;
            PG8_STAGE(PG8_SB(0, 1), b2 + hstepB, voffB);
            PG8_WAIT_V(6); PG8_BAR; PG8_MMA(1, 1, At, B1); PG8_BAR;
            PG8_LDB(B0, 1, 0); PG8_SCHED; PG8_LDA(At, 1, 0); PG8_STAGE(PG8_SA(0, 1), a2 + hstepA, voffA);
            PG8_WAIT_L(8); PG8_BAR; PG8_WAIT_L(0); PG8_MMA(0, 0, At, B0); PG8_BAR; PG8_SCHED;
            PG8_LDB(B1, 1, 1); PG8_STAGE(PG8_SB(1, 0), b3, voffB);
            PG8_BAR; PG8_WAIT_L(0); PG8_MMA(0, 1, At, B1); PG8_BAR;
            PG8_LDA(At, 1, 1); PG8_STAGE(PG8_SA(1, 0), a3, voffA);
            PG8_BAR; PG8_WAIT_L(0); PG8_MMA(1, 0, At, B0); PG8_BAR; PG8_SCHED;
            PG8_STAGE(PG8_SB(1, 1), b3 + hstepB, voffB);
            PG8_WAIT_V(6); PG8_BAR; PG8_MMA(1, 1, At, B1); PG8_BAR;
            }
        }
        if constexpr (ALIGN_EPI) { if (wr == 0) PG8_BAR; }
        E(acc, cur, wr, wc, fr, fq); S.done(cur);
        if (!has_next) break;
#pragma unroll
        for (int a = 0; a < 2; ++a)
#pragma unroll
            for (int b = 0; b < 2; ++b)
#pragma unroll
                for (int m = 0; m < 4; ++m)
#pragma unroll
                    for (int n = 0; n < 2; ++n) acc[a][b][m][n] = (f32x4){0.f, 0.f, 0.f, 0.f};
        cur = nxt; cA = nA; cB = nB; ++ui;
        if constexpr (ALIGN_EPI) { if (wr == 1) PG8_BAR; }
    }
    PG8_WAIT_V(0);
    if constexpr (!ALIGN_EPI) { if (wr == 0) PG8_BAR; }
    PG8_BAR;
#undef PG8_SA
#undef PG8_SB
#undef PG8_STAGE
#undef PG8_LDA
#undef PG8_LDB
#undef PG8_MMA
#undef PG8_WAIT_V
#undef PG8_WAIT_L
#undef PG8_BAR
#undef PG8_SCHED
#undef PG8_ABASE
#undef PG8_BBASE
}
}

#ifndef PG8_SP2
#define PG8_SP2 true
#endif
#ifndef PG8_ALIGN
#define PG8_ALIGN true
#endif

#define GAS __attribute__((address_space(1)))
#define LAS __attribute__((address_space(3)))
typedef unsigned short bf16;
typedef unsigned v4u __attribute__((ext_vector_type(4)));
typedef unsigned v2u __attribute__((ext_vector_type(2)));
typedef float f32x4 __attribute__((ext_vector_type(4)));
typedef short bf16x8 __attribute__((ext_vector_type(8)));
typedef short s16x4 __attribute__((ext_vector_type(4)));
typedef float f32x16 __attribute__((ext_vector_type(16)));
typedef GAS unsigned gu32;
#define RLX_AGENT __ATOMIC_RELAXED, __HIP_MEMORY_SCOPE_AGENT
#define LDS_WAIT() asm volatile("s_waitcnt lgkmcnt(0)" ::: "memory")
#define VM_WAIT() asm volatile("s_waitcnt vmcnt(0)" ::: "memory")
__device__ __forceinline__ unsigned cvtpk(float lo, float hi) { unsigned r; asm volatile("v_cvt_pk_bf16_f32 %0, %1, %2" : "=v"(r) : "v"(lo), "v"(hi)); return r; }
__device__ __forceinline__ float bflo(unsigned w) { return __uint_as_float(w << 16); }
__device__ __forceinline__ float bfhi(unsigned w) { return __uint_as_float(w & 0xffff0000u); }

#define XB_TMO      128
#define XB_XCNT(j)  (256  + 64 * (j))
#define XB_XSUB(j)  (1280 + 64 * (j))
#define XB_XGEN(j)  (2304 + 64 * (j))
#define XB_TOP      3328
#define XB_TOPGEN   3392
#define XCD_BAR_WORDS 3456
#define XB_SPIN_CAP (1u << 18)

__device__ __forceinline__ unsigned xb_ld(unsigned* p)              { return __hip_atomic_load(p, __ATOMIC_RELAXED, __HIP_MEMORY_SCOPE_AGENT); }
__device__ __forceinline__ unsigned xb_add(unsigned* p, unsigned v) { return __hip_atomic_fetch_add(p, v, __ATOMIC_RELAXED, __HIP_MEMORY_SCOPE_AGENT); }
__device__ __forceinline__ unsigned xb_xcc_id() { return (unsigned)__builtin_amdgcn_s_getreg((3 << 11) | 20) & 0xFu; }
#define XB_SPIN(cond, bar) do { unsigned _sp = 0; while (cond) { __builtin_amdgcn_s_sleep(1); \
    if ((++_sp & 255u) == 0u) { if (xb_ld(&(bar)[XB_TMO])) break; if (_sp > XB_SPIN_CAP) { atomicAdd(&(bar)[XB_TMO], 1u); break; } } } } while (0)

struct XcdBarrier {
    unsigned* bar; unsigned x;
    volatile LAS unsigned* st;
};
__device__ __forceinline__ XcdBarrier xcd_barrier_post(unsigned* bar, volatile LAS unsigned* st) {
    XcdBarrier b; b.bar = bar; b.x = xb_xcc_id(); b.st = st;
    if (threadIdx.x == 0) (void)xb_add(&bar[XB_XCNT(b.x)], 1u);
    return b;
}
__device__ __forceinline__ void xcd_barrier_complete(unsigned* bar, unsigned x, unsigned& nloc, unsigned& nx) {
    const unsigned G = gridDim.x * gridDim.y * gridDim.z;
    unsigned sum, cnt, mine, sp = 0u;
    for (;;) {
        sum = 0u; cnt = 0u; mine = 0u;
#pragma unroll
        for (unsigned j = 0; j < 16; ++j) { const unsigned c = xb_ld(&bar[XB_XCNT(j)]); sum += c; cnt += (c > 0u) ? 1u : 0u; mine = (j == x) ? c : mine; }
        if (sum == G) break;
        __builtin_amdgcn_s_sleep(1);
        if ((++sp & 255u) == 0u) { if (xb_ld(&bar[XB_TMO])) break; if (sp > XB_SPIN_CAP) { atomicAdd(&bar[XB_TMO], 1u); break; } }
    }
    nloc = mine > 0u ? mine : 1u; nx = cnt > 0u ? cnt : 1u;
}
__device__ __forceinline__ void xcd_barrier(const XcdBarrier& b) {
    asm volatile("s_waitcnt vmcnt(0)" ::: "memory");
    __syncthreads();
    if (threadIdx.x == 0) {
        unsigned* bar = b.bar;
        __builtin_amdgcn_s_waitcnt(0);
        unsigned nloc = b.st[0], nx = b.st[1];
        if (nloc == 0u) { xcd_barrier_complete(bar, b.x, nloc, nx); b.st[0] = nloc; b.st[1] = nx; }
        const unsigned old = xb_add(&bar[XB_XSUB(b.x)], 1u);
        const unsigned gen = old / nloc;
        if (old + 1u == (gen + 1u) * nloc) {
            __builtin_amdgcn_fence(__ATOMIC_RELEASE, "agent");
            asm volatile("s_waitcnt vmcnt(0)" ::: "memory");
            const unsigned og = xb_add(&bar[XB_TOP], 1u);
            const unsigned tg = og / nx;
            if (og + 1u == (tg + 1u) * nx) xb_add(&bar[XB_TOPGEN], 1u);
            else XB_SPIN(xb_ld(&bar[XB_TOPGEN]) == tg, bar);
            __builtin_amdgcn_fence(__ATOMIC_ACQUIRE, "agent");
            xb_add(&bar[XB_XGEN(b.x)], 1u);
            asm volatile("s_waitcnt vmcnt(0)" ::: "memory");
        } else {
            XB_SPIN(xb_ld(&bar[XB_XGEN(b.x)]) == gen, bar);
            __builtin_amdgcn_fence(__ATOMIC_ACQUIRE, "agent");
            asm volatile("s_waitcnt vmcnt(0)" ::: "memory");
        }
    }
    __syncthreads();
}

constexpr int NWAVES = 8;
constexpr int S = 8192, DM = 4096, NH = 32, HD = 128;
constexpr float RMS_EPS = 1e-6f;
constexpr float QSCALE = 0.08838834764831845f * 1.4426950408889634f;

constexpr size_t MiB = 1u << 20;
constexpr size_t WS_CTL = 0, CTL_ZERO_BYTES = 1 * MiB;
constexpr size_t WS_WAIN = 16 * MiB;
constexpr size_t WS_WAG = 144 * MiB;
constexpr size_t WS_WAOUT = 160 * MiB;
constexpr size_t WS_WKVQ = 224 * MiB;
constexpr size_t WS_WBIN1 = 352 * MiB;
constexpr size_t WS_WBOUT = 416 * MiB;
constexpr size_t WS_HB = 480 * MiB;
constexpr size_t WS_K = 544 * MiB;
constexpr size_t WS_V = 608 * MiB;
constexpr size_t WS_U = 672 * MiB;
constexpr size_t WS_SG = 736 * MiB;
constexpr size_t WS_PO = 800 * MiB;
constexpr size_t WS_Y = WS_SG;
constexpr size_t WS_END = 864 * MiB;
static_assert(WS_V == WS_K + 64 * MiB && WS_U == WS_V + 64 * MiB && WS_SG == WS_U + 64 * MiB && WS_PO == WS_SG + 64 * MiB, "EpiSeg segment layout");
constexpr size_t WS_RS = 512 * 1024;
constexpr int CW_BAR = 4096;
constexpr int CW_STEALQ = 8192;
constexpr int CW_DONE = 8256;

constexpr int RING_OFF = 0, RING_BYTES = 131072;
constexpr int LDSCTL_OFF = RING_BYTES, MISC_OFF = LDSCTL_OFF + 320;
constexpr int LDS_BYTES = 147456;
static_assert(MISC_OFF + 128 <= LDS_BYTES, "LDS map");

__device__ __forceinline__ float wave_sum(float v) {
#pragma unroll
    for (int o = 1; o < 64; o <<= 1) v += __shfl_xor(v, o);
    return v;
}

__device__ __forceinline__ void transpose_item(const float* __restrict__ W, int ldw, int N, bf16* __restrict__ WT, int ldt, int row_off, const float* __restrict__ gk, const float* __restrict__ gn,
                                               LAS unsigned char* scr, int item, int lane) {
    const int nblk = N >> 6, kb = item / nblk, nb = item - kb * nblk, k0 = kb << 6, n0 = nb << 6;
    const int nq = lane & 15, kr = lane >> 4;
    f32x4 va[8], vb[8];
#pragma unroll
    for (int i = 0; i < 8; ++i) { const int kp = 4 * i + kr; const float* p = W + (size_t)(k0 + 2 * kp) * ldw + n0 + 4 * nq; va[i] = __builtin_nontemporal_load((const f32x4*)p); vb[i] = __builtin_nontemporal_load((const f32x4*)(p + ldw)); }
    f32x4 gnv = (f32x4){1.f, 1.f, 1.f, 1.f}; if (gn) gnv = *(const f32x4*)(gn + n0 + 4 * nq);
    LAS unsigned* s32 = (LAS unsigned*)scr;
#pragma unroll
    for (int i = 0; i < 8; ++i) { const int kp = 4 * i + kr; float ga = 1.f, gb = 1.f; if (gk) { ga = gk[k0 + 2 * kp]; gb = gk[k0 + 2 * kp + 1]; }
        const f32x4 a = va[i] * ga * gnv, b = vb[i] * gb * gnv; const int wsw = kp ^ (4 * (nq & 7));
#pragma unroll
        for (int j = 0; j < 4; ++j) s32[(4 * nq + j) * 32 + wsw] = cvtpk(a[j], b[j]); }
    LDS_WAIT(); asm volatile("" ::: "memory");
    const int c = lane & 7;
#pragma unroll
    for (int pass = 0; pass < 8; ++pass) { const int n = (lane >> 3) + 8 * pass; const int ch = c ^ ((n >> 2) & 7);
        const v4u v = *(const LAS v4u*)(scr + n * 128 + ch * 16);
        __builtin_nontemporal_store(v, (v4u*)(WT + (size_t)(row_off + n0 + n) * ldt + k0 + 8 * c)); }
    LDS_WAIT(); asm volatile("" ::: "memory");
}
__device__ __forceinline__ void convert_row(const float* __restrict__ src, bf16* __restrict__ dst, float sc, int lane) {
    const f32x4* xr = (const f32x4*)src + 2 * lane; v4u* o8 = (v4u*)dst + lane; f32x4 v[16];
#pragma unroll
    for (int j = 0; j < 8; ++j) { v[2 * j] = xr[128 * j]; v[2 * j + 1] = xr[128 * j + 1]; }
#pragma unroll
    for (int j = 0; j < 8; ++j) { v4u w; w.x = cvtpk(v[2 * j].x * sc, v[2 * j].y * sc); w.y = cvtpk(v[2 * j].z * sc, v[2 * j].w * sc); w.z = cvtpk(v[2 * j + 1].x * sc, v[2 * j + 1].y * sc); w.w = cvtpk(v[2 * j + 1].z * sc, v[2 * j + 1].w * sc); o8[64 * j] = w; }
}
__device__ __forceinline__ void rms_row_to_bf16(const float* __restrict__ xrow, bf16* __restrict__ orow, float* __restrict__ rinv, int lane) {
    const f32x4* xr = (const f32x4*)xrow + lane;
    f32x4 v[16]; float s = 0.f;
#pragma unroll
    for (int j = 0; j < 16; ++j) { v[j] = xr[64 * j]; s += (v[j].x * v[j].x + v[j].y * v[j].y) + (v[j].z * v[j].z + v[j].w * v[j].w); }
    const float sd = sqrtf(wave_sum(s) * (1.f / DM) + RMS_EPS), rstd = 1.0f / sd;
    if (lane == 0) *rinv = sd;
    v2u* o8 = (v2u*)orow + lane;
#pragma unroll
    for (int j = 0; j < 16; ++j) { v2u w; w.x = cvtpk(v[j].x * rstd, v[j].y * rstd); w.y = cvtpk(v[j].z * rstd, v[j].w * rstd); o8[64 * j] = w; }
}
template <bool SRC_F32, bool OUT_F32>
__device__ __forceinline__ void norm_res_row(const float* __restrict__ xrow, bf16* hrow, float* rinv, const bf16* __restrict__ yrow, const float* __restrict__ g, float* __restrict__ xout, int lane) {
    const v4u* yr = (const v4u*)yrow + lane; const f32x4* gr = (const f32x4*)g + 2 * lane;
    v4u yw[8]; f32x4 x[16]; float s = 0.f;
#pragma unroll
    for (int j = 0; j < 8; ++j) yw[j] = yr[64 * j];
    if constexpr (SRC_F32) { const f32x4* xr = (const f32x4*)xrow + 2 * lane;
#pragma unroll
        for (int j = 0; j < 8; ++j) { x[2 * j] = xr[128 * j]; x[2 * j + 1] = xr[128 * j + 1]; } }
    else { const v4u* hr = (const v4u*)hrow + lane; v4u hw[8];
#pragma unroll
        for (int j = 0; j < 8; ++j) hw[j] = hr[64 * j];
        const float ri = *rinv;
#pragma unroll
        for (int j = 0; j < 8; ++j) { x[2 * j] = (f32x4){bflo(hw[j].x), bfhi(hw[j].x), bflo(hw[j].y), bfhi(hw[j].y)} * ri; x[2 * j + 1] = (f32x4){bflo(hw[j].z), bfhi(hw[j].z), bflo(hw[j].w), bfhi(hw[j].w)} * ri; } }
    f32x4 y[16];
#pragma unroll
    for (int j = 0; j < 8; ++j) { y[2 * j] = (f32x4){bflo(yw[j].x), bfhi(yw[j].x), bflo(yw[j].y), bfhi(yw[j].y)}; y[2 * j + 1] = (f32x4){bflo(yw[j].z), bfhi(yw[j].z), bflo(yw[j].w), bfhi(yw[j].w)}; }
#pragma unroll
    for (int j = 0; j < 16; ++j) s += (y[j].x * y[j].x + y[j].y * y[j].y) + (y[j].z * y[j].z + y[j].w * y[j].w);
    const float r1 = 1.0f / sqrtf(wave_sum(s) * (1.f / DM) + RMS_EPS);
    float s2 = 0.f;
#pragma unroll
    for (int j = 0; j < 16; ++j) { const f32x4 gg = gr[128 * (j >> 1) + (j & 1)]; x[j] = x[j] + (y[j] * r1) * gg; s2 += (x[j].x * x[j].x + x[j].y * x[j].y) + (x[j].z * x[j].z + x[j].w * x[j].w); }
    if constexpr (OUT_F32) { f32x4* xo = (f32x4*)xout + 2 * lane;
#pragma unroll
        for (int j = 0; j < 8; ++j) { xo[128 * j] = x[2 * j]; xo[128 * j + 1] = x[2 * j + 1]; } }
    else { const float var = wave_sum(s2) * (1.f / DM) + RMS_EPS, sd = sqrtf(var), r2 = 1.0f / sd; v4u* o8 = (v4u*)hrow + lane;
#pragma unroll
        for (int j = 0; j < 8; ++j) { v4u w; w.x = cvtpk(x[2 * j].x * r2, x[2 * j].y * r2); w.y = cvtpk(x[2 * j].z * r2, x[2 * j].w * r2); w.z = cvtpk(x[2 * j + 1].x * r2, x[2 * j + 1].y * r2); w.w = cvtpk(x[2 * j + 1].z * r2, x[2 * j + 1].w * r2); o8[64 * j] = w; }
        if (lane == 0) *rinv = sd; }
}
__device__ __forceinline__ void ld8f(const bf16* p, float (&f)[8]) { const v4u w = *(const v4u*)p; f[0] = bflo(w.x); f[1] = bfhi(w.x); f[2] = bflo(w.y); f[3] = bfhi(w.y); f[4] = bflo(w.z); f[5] = bfhi(w.z); f[6] = bflo(w.w); f[7] = bfhi(w.w); }
__device__ __forceinline__ void pool_block(const bf16* __restrict__ U, const bf16* __restrict__ SGp, bf16* __restrict__ PO, int rb, int tid) {
    const int c0 = tid * 8, w = 2 << (c0 >> 10), r0 = rb * 32;
    float s[8] = {0.f, 0.f, 0.f, 0.f, 0.f, 0.f, 0.f, 0.f};
    {
        v4u pre[16];
#pragma unroll
        for (int i = 0; i < 16; ++i) { const int row = r0 - 16 + i; pre[i] = *(const v4u*)(U + (size_t)(row < 0 ? 0 : row) * DM + c0); }
#pragma unroll
        for (int i = 0; i < 16; ++i) { const int row = r0 - 16 + i; const float m = (row >= r0 - w + 1 && row >= 0) ? 1.0f : 0.0f; const v4u q = pre[i];
            s[0] += m * bflo(q.x); s[1] += m * bfhi(q.x); s[2] += m * bflo(q.y); s[3] += m * bfhi(q.y); s[4] += m * bflo(q.z); s[5] += m * bfhi(q.z); s[6] += m * bflo(q.w); s[7] += m * bfhi(q.w); }
    }
    for (int b = 0; b < 4; ++b) {
        const int tb = r0 + 8 * b; v4u cur[8], sub[8], gt[8];
#pragma unroll
        for (int i = 0; i < 8; ++i) { const int t = tb + i, ts = t - w + 1; cur[i] = *(const v4u*)(U + (size_t)t * DM + c0); gt[i] = *(const v4u*)(SGp + (size_t)t * DM + c0);
            sub[i] = *(const v4u*)(U + (size_t)(ts < 0 ? 0 : ts) * DM + c0); }
#pragma unroll
        for (int i = 0; i < 8; ++i) { const int t = tb + i, ts = t - w + 1; const int cnt = (t + 1 < w) ? (t + 1) : w; const float inv = 1.0f / (float)cnt, ms = (ts >= 0) ? 1.0f : 0.0f;
            const float c[8] = {bflo(cur[i].x), bfhi(cur[i].x), bflo(cur[i].y), bfhi(cur[i].y), bflo(cur[i].z), bfhi(cur[i].z), bflo(cur[i].w), bfhi(cur[i].w)};
            const float g[8] = {bflo(gt[i].x), bfhi(gt[i].x), bflo(gt[i].y), bfhi(gt[i].y), bflo(gt[i].z), bfhi(gt[i].z), bflo(gt[i].w), bfhi(gt[i].w)};
            const float u[8] = {bflo(sub[i].x), bfhi(sub[i].x), bflo(sub[i].y), bfhi(sub[i].y), bflo(sub[i].z), bfhi(sub[i].z), bflo(sub[i].w), bfhi(sub[i].w)};
            float o[8];
#pragma unroll
            for (int j = 0; j < 8; ++j) { s[j] += c[j]; o[j] = (s[j] * inv - c[j]) * g[j]; s[j] -= ms * u[j]; }
            v4u wv; wv.x = cvtpk(o[0], o[1]); wv.y = cvtpk(o[2], o[3]); wv.z = cvtpk(o[4], o[5]); wv.w = cvtpk(o[6], o[7]);
            *(v4u*)(PO + (size_t)t * DM + c0) = wv; }
    }
}

namespace sb {
constexpr int NW = 8, QBLK = 32, QB = 128, KVBLK = 64, PITCH = DM;
constexpr int SHM_T = KVBLK * HD * 2, HEAD_B = 2 * SHM_T, BUF_B = 2 * HEAD_B;
static_assert(2 * BUF_B <= RING_BYTES, "attention LDS");
#define KSWZ(row, colB) ((row) * 256 + ((colB) ^ (((row) & 7) << 4)))
#define SBAR() __builtin_amdgcn_sched_barrier(0)
__device__ __forceinline__ int v_rd_base(int lane) { return ((lane & 3) << 3) | (((lane >> 2) & 3) << 6) | (((lane >> 4) & 1) << 5) | (((lane >> 5) & 1) << 8); }
constexpr int v_rd_off(int d0, int ks, int half) { return d0 * 512 + ks * 4096 + half * 2048; }
__device__ __forceinline__ int crow(int r, int hi) { return (r & 3) + 8 * (r >> 2) + 4 * hi; }

__device__ __forceinline__ void qkt(f32x16& p0, f32x16& p1, const LAS char* Kb, int r32, int hi, const bf16x8* qr) {
    p0 = f32x16{}; p1 = f32x16{};
    const LAS char* kb[4];
#pragma unroll
    for (int dd = 0; dd < 4; ++dd) kb[dd] = Kb + KSWZ(r32, (dd * 16 + hi * 8) * 2);
    bf16x8 kf0[8], kf1[8];
#pragma unroll
    for (int d0 = 0; d0 < 8; ++d0) { const LAS char* a = kb[d0 & 3] + (d0 >> 2) * 128; kf0[d0] = *(const LAS bf16x8*)a; kf1[d0] = *(const LAS bf16x8*)(a + 32 * 256); }
    SBAR();
#pragma unroll
    for (int d0 = 0; d0 < 8; ++d0) { p0 = __builtin_amdgcn_mfma_f32_32x32x16_bf16(kf0[d0], qr[d0], p0, 0, 0, 0); p1 = __builtin_amdgcn_mfma_f32_32x32x16_bf16(kf1[d0], qr[d0], p1, 0, 0, 0); }
}
__device__ __forceinline__ void pv_tile(f32x16* o, int vb, bf16x8 pa0, bf16x8 pa1, bf16x8 pa2, bf16x8 pa3) {
#define TRRD(dst, off) asm volatile("ds_read_b64_tr_b16 %0, %1 offset:%2" : "=&v"(dst) : "v"(vb), "i"(off) : "memory")
#define TR8(L, H, ks) do { TRRD(L[0], v_rd_off(0, ks, 0)); TRRD(H[0], v_rd_off(0, ks, 1)); TRRD(L[1], v_rd_off(1, ks, 0)); TRRD(H[1], v_rd_off(1, ks, 1)); \
        TRRD(L[2], v_rd_off(2, ks, 0)); TRRD(H[2], v_rd_off(2, ks, 1)); TRRD(L[3], v_rd_off(3, ks, 0)); TRRD(H[3], v_rd_off(3, ks, 1)); } while (0)
#define VF(L, H, d) (bf16x8){L[d][0], L[d][1], L[d][2], L[d][3], H[d][0], H[d][1], H[d][2], H[d][3]}
#define MM4(pa, L, H) do { o[0] = __builtin_amdgcn_mfma_f32_32x32x16_bf16(pa, VF(L, H, 0), o[0], 0, 0, 0); o[1] = __builtin_amdgcn_mfma_f32_32x32x16_bf16(pa, VF(L, H, 1), o[1], 0, 0, 0); \
        o[2] = __builtin_amdgcn_mfma_f32_32x32x16_bf16(pa, VF(L, H, 2), o[2], 0, 0, 0); o[3] = __builtin_amdgcn_mfma_f32_32x32x16_bf16(pa, VF(L, H, 3), o[3], 0, 0, 0); } while (0)
    { s16x4 la[4], ha[4], lb[4], hb[4];
      TR8(la, ha, 0); TR8(lb, hb, 1);
      asm volatile("s_waitcnt lgkmcnt(8)" ::: "memory"); SBAR(); MM4(pa0, la, ha); SBAR();
      { s16x4 lc[4], hc[4]; TR8(lc, hc, 2);
        asm volatile("s_waitcnt lgkmcnt(8)" ::: "memory"); SBAR(); MM4(pa1, lb, hb); SBAR();
        { s16x4 ld[4], hd[4]; TR8(ld, hd, 3);
          asm volatile("s_waitcnt lgkmcnt(8)" ::: "memory"); SBAR(); MM4(pa2, lc, hc); SBAR();
          asm volatile("s_waitcnt lgkmcnt(0)" ::: "memory"); SBAR(); MM4(pa3, ld, hd); SBAR(); } } }
#undef MM4
#undef VF
#undef TR8
#undef TRRD
}
__device__ __forceinline__ void sb_weights(f32x16& p0, f32x16& p1, float& C, int hi, bf16x8& pa0, bf16x8& pa1, bf16x8& pa2, bf16x8& pa3) {
    float G[8];
#pragma unroll
    for (int Q = 0; Q < 8; ++Q) {
        f32x16& p = (Q < 4) ? p0 : p1; const int rb = (Q & 3) * 4;
        const float o0 = __builtin_amdgcn_rcpf(1.0f + __builtin_amdgcn_exp2f(p[rb + 0])), o1 = __builtin_amdgcn_rcpf(1.0f + __builtin_amdgcn_exp2f(p[rb + 1]));
        const float o2 = __builtin_amdgcn_rcpf(1.0f + __builtin_amdgcn_exp2f(p[rb + 2])), o3 = __builtin_amdgcn_rcpf(1.0f + __builtin_amdgcn_exp2f(p[rb + 3]));
        const float E1 = o3 * o2, E0 = E1 * o1; G[Q] = E0 * o0;
        p[rb + 3] = 1.0f - o3; p[rb + 2] = o3 - E1; p[rb + 1] = E1 - E0; p[rb + 0] = E0 - G[Q];
    }
    float R = C;
#pragma unroll
    for (int Q = 7; Q >= 0; --Q) {
        f32x16& p = (Q < 4) ? p0 : p1; const int rb = (Q & 3) * 4;
        const auto rr = __builtin_amdgcn_permlane32_swap(__float_as_uint(G[Q]), __float_as_uint(G[Q]), false, false);
        const float g0 = __uint_as_float(rr[0]), g1 = __uint_as_float(rr[1]);
        const float X = R * g1;
        const float Sq = hi ? R : X;
        R = X * g0;
        p[rb + 0] *= Sq; p[rb + 1] *= Sq; p[rb + 2] *= Sq; p[rb + 3] *= Sq;
    }
    C = R;
#define PK4(P, B_, OUT) do { const unsigned a0 = cvtpk(P[B_ + 0], P[B_ + 1]), a1 = cvtpk(P[B_ + 2], P[B_ + 3]); \
        const unsigned b0 = cvtpk(P[B_ + 4], P[B_ + 5]), b1 = cvtpk(P[B_ + 6], P[B_ + 7]); \
        const auto r0 = __builtin_amdgcn_permlane32_swap(a0, b0, false, false); const auto r1 = __builtin_amdgcn_permlane32_swap(a1, b1, false, false); \
        v4u w = {r0[0], r1[0], r0[1], r1[1]}; OUT = __builtin_bit_cast(bf16x8, w); } while (0)
    PK4(p0, 0, pa0); PK4(p0, 8, pa1); PK4(p1, 0, pa2); PK4(p1, 8, pa3);
#undef PK4
}

__device__ __forceinline__ void attn_unit(int hp, int qb, const bf16* Q, const bf16* __restrict__ Kt, const bf16* __restrict__ Vt, const bf16* __restrict__ SG, bf16* O, LAS char* lds, volatile LAS unsigned* flags) {
    int tid = threadIdx.x; asm volatile("" : "+v"(tid));
    const int wid = __builtin_amdgcn_readfirstlane(tid >> 6), lane = tid & 63, r32 = lane & 31, hi = lane >> 5;
    const int sub = wid & 3, hh = wid >> 2, h = 2 * hp + hh;
    const int P0 = qb * QB, qlo = P0 + sub * QBLK;
    const bf16* Qh = Q + h * HD;
    bf16x8 qr[8];
#pragma unroll
    for (int d0 = 0; d0 < 8; ++d0) qr[d0] = *(const bf16x8*)(Qh + (size_t)(qlo + r32) * PITCH + d0 * 16 + hi * 8);
    const int tileid = wid >> 1, shalf = wid & 1, sh = tileid >> 1, isV = tileid & 1;
    const bf16* Sb = (isV ? Vt : Kt) + (2 * hp + sh) * HD;
    const int rowl = lane >> 4;
    const int offE = isV ? (8 * ((lane >> 4) & 1) + ((lane >> 2) & 3)) * PITCH + 32 * (lane >> 5) + 8 * (lane & 3) : rowl * PITCH + (((lane & 15) ^ rowl) << 3);
    const int offO = isV ? offE + 64 : rowl * PITCH + (((lane & 15) ^ (4 + rowl)) << 3);
    LAS char* sdst = lds + sh * HEAD_B + isV * SHM_T + shalf * 8192;
#define STAGE(j, buf) do { const bf16* sp_ = Sb + (size_t)(j) * KVBLK * PITCH; _Pragma("unroll") for (int ii = 0; ii < 8; ++ii) { \
        const int rterm = isV ? (32 * shalf + 16 * (ii >> 2) + 4 * ((ii >> 1) & 1)) * PITCH : (32 * shalf + 4 * ii) * PITCH; \
        __builtin_amdgcn_global_load_lds((const unsigned*)(sp_ + rterm + ((ii & 1) ? offO : offE)), (LAS unsigned*)(sdst + (buf) * BUF_B + ii * 1024), 16, 0, 0); } } while (0)
    const int vb0 = (int)(unsigned)(uintptr_t)(lds + hh * HEAD_B + SHM_T) + v_rd_base(lane);
    const LAS char* K_lds = lds + hh * HEAD_B;
    const int j_hi = 2 * qb + 2;
    STAGE(j_hi - 1, 0);
    VM_WAIT();
    __syncthreads();
    float C = 1.0f; bool done = false; f32x16 o[4] = {};
    for (int t = 0;; ++t) {
        const int j = j_hi - 1 - t, buf = t & 1;
        if (j > 0) STAGE(j - 1, buf ^ 1);
        const bool act = !done && (j * KVBLK <= qlo + QBLK - 1);
        if (act) {
            f32x16 p0, p1; bf16x8 pa0, pa1, pa2, pa3;
            qkt(p0, p1, K_lds + buf * BUF_B, r32, hi, qr);
            if (j * KVBLK + KVBLK - 1 >= qlo) {
                const int dq = qlo + r32 - 4 * hi - j * KVBLK; const float NEG = -__builtin_inff();
#pragma unroll
                for (int r = 0; r < 16; ++r) { const int c = (r & 3) + 8 * (r >> 2); if (dq - c <= 0) p0[r] = NEG; if (dq - c - 32 <= 0) p1[r] = NEG; }
            }
            sb_weights(p0, p1, C, hi, pa0, pa1, pa2, pa3);
            pv_tile(o, vb0 + buf * BUF_B, pa0, pa1, pa2, pa3);
#if SB_EARLY_EXIT
            if (__all(C == 0.0f)) done = true;
#endif
        }
#if SB_EARLY_EXIT
        if (lane == 0) flags[buf * NW + wid] = done ? 1u : 0u;
#endif
        VM_WAIT();
        __syncthreads();
        if (j == 0) break;
#if SB_EARLY_EXIT
        { asm volatile("" ::: "memory");
          const v4u fa = *(const LAS v4u*)(const_cast<LAS unsigned*>(flags) + buf * NW), fb = *(const LAS v4u*)(const_cast<LAS unsigned*>(flags) + buf * NW + 4);
          const unsigned nd = (fa.x + fa.y) + (fa.z + fa.w) + (fb.x + fb.y) + (fb.z + fb.w);
          if (nd == (unsigned)NW) break; }
#endif
    }
#undef STAGE
    LAS bf16* stg = (LAS bf16*)(lds + wid * 8192);
#pragma unroll
    for (int r = 0; r < 16; ++r) { const int orow = crow(r, hi);
#pragma unroll
        for (int d0 = 0; d0 < 4; ++d0) { const unsigned w = cvtpk(o[d0][r], 0.f); stg[orow * HD + d0 * 32 + r32] = (bf16)(w & 0xffffu); } }
    LDS_WAIT(); asm volatile("" ::: "memory");
#pragma unroll
    for (int i = 0; i < 8; ++i) { const int row = i * 4 + (lane >> 4), ch = lane & 15;
        const v4u v = *(const LAS v4u*)(stg + row * HD + ch * 8);
        const size_t off = (size_t)(qlo + row) * PITCH + h * HD + ch * 8;
        const v4u g = *(const v4u*)(SG + off);
        v4u w; w.x = cvtpk(bflo(v.x) * bflo(g.x), bfhi(v.x) * bfhi(g.x)); w.y = cvtpk(bflo(v.y) * bflo(g.y), bfhi(v.y) * bfhi(g.y));
        w.z = cvtpk(bflo(v.z) * bflo(g.z), bfhi(v.z) * bfhi(g.z)); w.w = cvtpk(bflo(v.w) * bflo(g.w), bfhi(v.w) * bfhi(g.w));
        *(v4u*)(O + off) = w; }
    __syncthreads();
}
#undef KSWZ
#undef SBAR
}

constexpr int DEF_I_IN = (DM / 64) * (2 * DM / 64), DEF_I_OUT = (DM / 64) * (DM / 64), DEF_N = 3 * DEF_I_IN + 2 * DEF_I_OUT;
struct Args; typedef const __attribute__((address_space(4))) Args* KArgs;
__device__ __forceinline__ void deferred_item(int r, const float* w_kv, const float* kv_norm, const float* b_w_in, const float* b_pre, const float* b_w_out, unsigned char* ws, LAS unsigned char* scr, int lane) {
    const float* W; int ld; bf16* WT; int row_off = 0; const float* gk;
    if (r < DEF_I_IN) { W = w_kv; ld = 2 * DM; WT = (bf16*)(ws + WS_WKVQ); gk = kv_norm; }
    else if (r < 2 * DEF_I_IN) { r -= DEF_I_IN; W = b_w_in; ld = 2 * DM; WT = (bf16*)(ws + WS_WKVQ); row_off = 2 * DM; gk = b_pre; }
    else if (r < 3 * DEF_I_IN) { r -= 2 * DEF_I_IN; W = b_w_in + (size_t)DM * 2 * DM; ld = 2 * DM; WT = (bf16*)(ws + WS_WBIN1); gk = b_pre + DM; }
    else { r -= 3 * DEF_I_IN; const int l = r / DEF_I_OUT; r -= l * DEF_I_OUT; W = b_w_out + (size_t)l * DM * DM; ld = DM; WT = (bf16*)(ws + WS_WBOUT) + (size_t)l * DM * DM; gk = nullptr; }
    transpose_item(W, ld, ld, WT, DM, row_off, gk, nullptr, scr, r, lane);
}

struct Args { const float* in[13]; float* out; unsigned char* ws; };
typedef const __attribute__((address_space(4))) Args* KArgs;
#define PHASE_ARGS() KArgs ka = ka0; asm volatile("" : "+s"(ka)); unsigned char* const ws = ka->ws; (void)ws; \
    int tid = threadIdx.x; asm volatile("" : "+v"(tid)); const int lane = tid & 63, wave = __builtin_amdgcn_readfirstlane(tid >> 6); (void)lane; (void)wave; \
    const int G = gridDim.x, bx = blockIdx.x, gw = bx * NWAVES + wave, NGW = G * NWAVES; (void)gw; (void)NGW
__global__ void __launch_bounds__(NWAVES * 64, 2) yoco_fwd(Args args_unused) {
    extern __shared__ __attribute__((aligned(16))) unsigned char lds_raw[];
    LAS unsigned char* lds = (LAS unsigned char*)lds_raw;
    const KArgs ka0 = (KArgs)__builtin_amdgcn_kernarg_segment_ptr();
    XcdBarrier bar;
    {
        volatile LAS unsigned* MISC = (volatile LAS unsigned*)(lds + MISC_OFF);
        for (int u = threadIdx.x; u < (LDS_BYTES - LDSCTL_OFF) / 4; u += NWAVES * 64) ((LAS unsigned*)(lds + LDSCTL_OFF))[u] = 0u;
        __syncthreads();
        bar = xcd_barrier_post((unsigned*)(ka0->ws + WS_CTL) + CW_BAR, MISC + 8);
    }
#define GRID_BAR() xcd_barrier(bar)

#define STEAL(site, limit) do { PHASE_ARGS(); gu32* ctl_ = (gu32*)(ws + WS_CTL); volatile LAS unsigned* sh_ = (volatile LAS unsigned*)(lds + LDSCTL_OFF + 128); \
        const float* w_kv_ = ka->in[8]; const float* kvn_ = ka->in[7]; const float* bwi_ = ka->in[10]; const float* bpre_ = ka->in[9]; const float* bwo_ = ka->in[11]; \
        asm volatile("s_waitcnt vmcnt(0)" ::: "memory"); __syncthreads(); \
        if ((site) >= 0 && tid == 0) __hip_atomic_fetch_add(ctl_ + CW_DONE + 64 * ((site) < 0 ? 0 : (site)), 1u, RLX_AGENT); \
        for (int par_ = 0;; par_ ^= 1) { \
            if (tid == 0) { unsigned stop_ = 0u, base_ = 0u; \
                if ((site) >= 0 && __hip_atomic_load(ctl_ + CW_DONE + 64 * ((site) < 0 ? 0 : (site)), RLX_AGENT) >= (unsigned)G) stop_ = 1u; \
                else if ((site) < 0 && __hip_atomic_load(ctl_ + CW_STEALQ, RLX_AGENT) >= (unsigned)(limit)) stop_ = 1u;     \
                else { base_ = __hip_atomic_fetch_add(ctl_ + CW_STEALQ, 16u, RLX_AGENT); if (base_ >= (unsigned)DEF_N) stop_ = 1u; } \
                sh_[2 * par_] = base_; sh_[2 * par_ + 1] = stop_; } \
            __syncthreads(); \
            const unsigned base_ = sh_[2 * par_], stop_ = sh_[2 * par_ + 1]; \
            if (stop_) break; \
            for (int rep_ = 0; rep_ < 2; ++rep_) { const int item_ = (int)base_ + 8 * rep_ + wave; \
                if (item_ < DEF_N) deferred_item(item_, w_kv_, kvn_, bwi_, bpre_, bwo_, ws, lds + RING_OFF + wave * 8192, lane); } } } while (0)

    {
        PHASE_ARGS();
        const float* a_pre = ka->in[1]; const float* a_w_in = ka->in[2]; const float* a_w_group = ka->in[3]; const float* a_scale = ka->in[4];
        bf16* WAG = (bf16*)(ws + WS_WAG);
        LAS unsigned char* scr = lds + RING_OFF + wave * 8192;
        constexpr int I_G = (1024 / 64) * (1024 / 64);
        constexpr int I_ROW = 2 * DM;
        bf16* WINU = (bf16*)(ws + WS_PO);
        for (int it = gw; it < I_ROW + 8 * I_G; it += NGW) {
            int r = it;
            if (r < I_ROW) { const int l = r >> 12, k = r & 4095; convert_row(a_w_in + (size_t)l * DM * 2 * DM + (size_t)k * 2 * DM, WINU + (size_t)k * 2 * DM + l * DM, a_pre[l * DM + k], lane); continue; } r -= I_ROW;
            { const int lg = r / I_G; r -= lg * I_G; const int l = lg >> 2, gq = lg & 3;
              transpose_item(a_w_group + (size_t)lg * 1024 * 1024, 1024, 1024, WAG + (size_t)l * DM * 1024, 1024, gq * 1024, nullptr, a_scale + l * DM + gq * 1024, scr, r, lane); }
        }
    }
    GRID_BAR();
#define P0_REST() do { PHASE_ARGS(); \
        const float* a_pre = ka->in[1]; const float* a_w_in = ka->in[2]; const float* a_w_out = ka->in[5]; \
        bf16* WAIN = (bf16*)(ws + WS_WAIN); bf16* WAOUT = (bf16*)(ws + WS_WAOUT); \
        LAS unsigned char* scr = lds + RING_OFF + wave * 8192; \
        constexpr int I_OUT = (DM / 64) * (DM / 64);           \
        for (int it = gw; it < 4 * I_OUT; it += NGW) { \
            int r = it; \
            if (r < 2 * I_OUT) { const int l = r / I_OUT; r -= l * I_OUT;     \
                transpose_item(a_w_in + (size_t)l * DM * 2 * DM + DM, 2 * DM, DM, WAIN + (size_t)l * 2 * DM * DM, DM, DM, a_pre + l * DM, nullptr, scr, r, lane); continue; } r -= 2 * I_OUT; \
            { const int l = r / I_OUT; r -= l * I_OUT; transpose_item(a_w_out + (size_t)l * DM * DM, DM, DM, WAOUT + (size_t)l * DM * DM, DM, 0, nullptr, nullptr, scr, r, lane); } \
        } \
        const float* x_in = ka->in[0]; bf16* HB = (bf16*)(ws + WS_HB); \
        float* RS = (float*)(ws + WS_RS); for (int m = gw; m < S; m += NGW) rms_row_to_bf16(x_in + (size_t)m * DM, HB + (size_t)m * DM, RS + m, lane); \
        asm volatile("s_waitcnt vmcnt(0) lgkmcnt(0)" ::: "memory"); __syncthreads(); } while (0)
    const bool conv_first = ((blockIdx.x >> 3) & 1) != 0;
    if (conv_first) P0_REST();
    {
        PHASE_ARGS();
        pg8::Gemm g{(const bf16*)(ws + WS_WAG), (const bf16*)(ws + WS_PO), 2 * DM, DM, 1024, 1024, 2 * DM, 1 << 20, 4}; pg8::StaticOrder So; So.init(2 * DM, DM, G, bx);
        pg8::EpiSeg<false> E{(bf16*)(ws + WS_WAIN), -1, -1, 1.f, nullptr, DM, DM};
        pg8::gemm_phase<pg8::EpiSeg<false>, pg8::StaticOrder, PG8_ALIGN, PG8_SP2>(lds + RING_OFF, g, So, E);
    }
    if (!conv_first) P0_REST();
#undef P0_REST
    STEAL(0, DEF_N);
    GRID_BAR();

    for (int l = 0; l < 2; ++l) {
        {
            PHASE_ARGS();
            pg8::Gemm g{(const bf16*)(ws + WS_HB), (const bf16*)(ws + WS_WAIN) + (size_t)l * 2 * DM * DM, S, 2 * DM, DM, DM, DM, 1 << 20, 1 << 20}; pg8::StaticOrder So; So.init(S, 2 * DM, G, bx);
            pg8::EpiSeg<false> E{(bf16*)(ws + WS_U), -1, 1, 1.f, nullptr, 1 << 30, 0};
            pg8::gemm_phase<pg8::EpiSeg<false>, pg8::StaticOrder, PG8_ALIGN, PG8_SP2>(lds + RING_OFF, g, So, E);
        }
        STEAL(1 + 2 * l, DEF_N);
        GRID_BAR();
        {
            PHASE_ARGS();
            for (int rb = bx; rb < S / 32; rb += G) pool_block((const bf16*)(ws + WS_U), (const bf16*)(ws + WS_SG), (bf16*)(ws + WS_PO), rb, tid);
        }
        GRID_BAR();
        {
            PHASE_ARGS();
            pg8::Gemm g{(const bf16*)(ws + WS_PO), (const bf16*)(ws + WS_WAOUT) + (size_t)l * DM * DM, S, DM, DM, DM, DM, 1 << 20, 1 << 20}; pg8::StaticOrder So; So.init(S, DM, G, bx);
            pg8::EpiSeg<false> E{(bf16*)(ws + WS_Y), -1, -1, 1.f, nullptr, 1 << 30, 0};
            pg8::gemm_phase<pg8::EpiSeg<false>, pg8::StaticOrder, PG8_ALIGN, PG8_SP2>(lds + RING_OFF, g, So, E);
        }
        STEAL(2 + 2 * l, DEF_N);
        GRID_BAR();
        {
            PHASE_ARGS();
            const float* gp = ka->in[6] + l * DM; float* RS = (float*)(ws + WS_RS);
            const bf16* YB = (const bf16*)(ws + WS_Y); bf16* HB = (bf16*)(ws + WS_HB);
            for (int m = gw; m < S; m += NGW) norm_res_row<false, false>(nullptr, HB + (size_t)m * DM, RS + m, YB + (size_t)m * DM, gp, nullptr, lane);
        }
        if (l == 1) STEAL(-1, 2 * DEF_I_IN);
        GRID_BAR();
    }

    for (int jl = 0; jl < 2; ++jl) {
        {
            PHASE_ARGS();
            const int N = (jl == 0) ? 4 * DM : 2 * DM;
            pg8::Gemm g{(const bf16*)(ws + WS_HB), (const bf16*)(ws + ((jl == 0) ? WS_WKVQ : WS_WBIN1)), S, N, DM, DM, DM, 1 << 20, 1 << 20}; pg8::StaticOrder So; So.init(S, N, G, bx);
            pg8::EpiSeg<false> E{(bf16*)(ws + ((jl == 0) ? WS_K : WS_U)), (jl == 0) ? 2 : 0, (jl == 0) ? 3 : 1, QSCALE, nullptr, 1 << 30, 0};
            pg8::gemm_phase<pg8::EpiSeg<false>, pg8::StaticOrder, PG8_ALIGN, PG8_SP2>(lds + RING_OFF, g, So, E);
        }
        STEAL(5 + jl, DEF_N);
        GRID_BAR();
        {
            PHASE_ARGS();
            bf16* UB = (bf16*)(ws + WS_U); const bf16* KB = (const bf16*)(ws + WS_K); const bf16* VB = (const bf16*)(ws + WS_V); const bf16* SGB = (const bf16*)(ws + WS_SG);
            const unsigned mode_dn = __builtin_amdgcn_s_getreg((2 - 1) << 11 | 4 << 6 | 1);
            __builtin_amdgcn_s_setreg((2 - 1) << 11 | 4 << 6 | 1, 0u);
            for (int u = bx; u < 1024; u += G) { const int xcd = u & 7, k = u >> 3, hp = xcd + 8 * (k >> 6), qb = 63 - (k & 63);
                sb::attn_unit(hp, qb, UB, KB, VB, SGB, UB, (LAS char*)(lds + RING_OFF), (volatile LAS unsigned*)(lds + LDSCTL_OFF)); }
            __builtin_amdgcn_s_setreg((2 - 1) << 11 | 4 << 6 | 1, mode_dn);
        }
        STEAL(-1, 3 * DEF_I_IN + (jl + 1) * DEF_I_OUT);
        GRID_BAR();
        {
            PHASE_ARGS();
            pg8::Gemm g{(const bf16*)(ws + WS_U), (const bf16*)(ws + WS_WBOUT) + (size_t)jl * DM * DM, S, DM, DM, DM, DM, 1 << 20, 1 << 20}; pg8::StaticOrder So; So.init(S, DM, G, bx);
            pg8::EpiSeg<false> E{(bf16*)(ws + WS_Y), -1, -1, 1.f, nullptr, 1 << 30, 0};
            pg8::gemm_phase<pg8::EpiSeg<false>, pg8::StaticOrder, PG8_ALIGN, PG8_SP2>(lds + RING_OFF, g, So, E);
        }
        GRID_BAR();
        {
            PHASE_ARGS();
            float* xout = ka->out; const float* gp = ka->in[12] + jl * DM; const bf16* YB = (const bf16*)(ws + WS_Y); bf16* HB = (bf16*)(ws + WS_HB); float* RS = (float*)(ws + WS_RS);
            if (jl == 0) { for (int m = gw; m < S; m += NGW) norm_res_row<false, false>(nullptr, HB + (size_t)m * DM, RS + m, YB + (size_t)m * DM, gp, nullptr, lane); }
            else { for (int m = gw; m < S; m += NGW) norm_res_row<false, true>(nullptr, HB + (size_t)m * DM, RS + m, YB + (size_t)m * DM, gp, xout + (size_t)m * DM, lane); }
        }
        if (jl == 0) GRID_BAR();
    }
#undef GRID_BAR
}

extern "C" void kernel_launch(void* const* d_in, const int* in_sizes, int n_in, void* d_out, int out_size, void* d_ws, size_t ws_size, hipStream_t stream) {
    static int grid = 0;
    if (grid == 0) {
        if (n_in != 13 || in_sizes[0] != S * DM || out_size != S * DM || ws_size < WS_END) {
            fprintf(stderr, "kernel_launch: unexpected shapes (n_in %d, in0 %d, out %d, ws %zu); nothing launched\n", n_in, n_in > 0 ? in_sizes[0] : -1, out_size, ws_size); grid = -1; return; }
        int dev = 0, cus = 0, per_cu = 0;
        if (hipGetDevice(&dev) != hipSuccess || hipDeviceGetAttribute(&cus, hipDeviceAttributeMultiprocessorCount, dev) != hipSuccess) { fprintf(stderr, "kernel_launch: device query failed\n"); grid = -1; return; }
        if (hipFuncSetAttribute((const void*)yoco_fwd, hipFuncAttributeMaxDynamicSharedMemorySize, LDS_BYTES) != hipSuccess) { fprintf(stderr, "kernel_launch: hipFuncSetAttribute failed\n"); grid = -1; return; }
        if (hipOccupancyMaxActiveBlocksPerMultiprocessor(&per_cu, (const void*)yoco_fwd, NWAVES * 64, LDS_BYTES) != hipSuccess || per_cu < 1)
            fprintf(stderr, "kernel_launch: note: occupancy query reports %d workgroups per CU\n", per_cu);
        (void)hipGetLastError();
        grid = cus;
    }
    if (grid < 0) return;
    if (hipMemsetAsync((char*)d_ws + WS_CTL, 0, CTL_ZERO_BYTES, stream) != hipSuccess) { fprintf(stderr, "kernel_launch: memset failed\n"); return; }
    Args a{};
    for (int i = 0; i < 13; ++i) a.in[i] = (const float*)d_in[i];
    a.out = (float*)d_out; a.ws = (unsigned char*)d_ws;
    hipLaunchKernelGGL(yoco_fwd, dim3(grid), dim3(NWAVES * 64), LDS_BYTES, stream, a);
    const hipError_t le = hipPeekAtLastError();
    if (le != hipSuccess) fprintf(stderr, "kernel_launch: launch failed: %s\n", hipGetErrorName(le));
}
```
